# Optimizing an MI355X kernel written in HIP

```python
import jax, jax.numpy as jnp
from jax import lax
import numpy as np

D_MODEL = 1024
BATCH = 8
SEQ = 2048
DEPTH = 2
DEC_BATCH = 128
DEC_SEQ = 8
PAST_LEN = 16384
PAGE_SIZE = 128

D_MIX = D_MODEL
HEAD_DIM = 64
W_CONV = D_MIX // 4
W_GMLP = D_MIX // 2
W_POOL = D_MIX - W_CONV - W_GMLP
N_GMLP_HEADS = W_GMLP // HEAD_DIM
POOL_WINDOWS = (2, 4, 8, 16)
N_POOL_GROUPS = len(POOL_WINDOWS)
POOL_GROUP_DIM = W_POOL // N_POOL_GROUPS
CONV_WIDTH = 3
CONV_BUF = CONV_WIDTH - 1
POOL_BUF = max(POOL_WINDOWS) - 1
CHUNK = 128
D_FF = 4 * D_MODEL
D_IN_PROJ = 3 * W_CONV + 2 * W_GMLP + W_POOL
DEEPNORM_ALPHA = (2.0 * DEPTH) ** 0.25
DEEPNORM_BETA = (8.0 * DEPTH) ** -0.25
LN_EPS = 1e-5

kernel_name = "hymba_conv_gmlp_pool_deepnorm_adaln_step"


def layer_norm(x, g, b):
    xf = x.astype(jnp.float32)
    mu = jnp.mean(xf, axis=-1, keepdims=True)
    var = jnp.mean(jnp.square(xf - mu), axis=-1, keepdims=True)
    y = (xf - mu) * lax.rsqrt(var + LN_EPS)
    return (y * g.astype(jnp.float32) + b.astype(jnp.float32)).astype(x.dtype)


def short_conv(z, prefix, conv_w):
    t = z.shape[1]
    ext = jnp.concatenate([prefix, z], axis=1)
    y = ext[:, 0:t] * conv_w[0] + ext[:, 1:t + 1] * conv_w[1] + ext[:, 2:t + 2] * conv_w[2]
    return y, ext[:, -CONV_BUF:]


def chunk_sgu(u, v, sgu_g, sgu_b, w_s, b_s):
    bsz, t, _ = v.shape
    v_n = layer_norm(v, sgu_g, sgu_b)
    lc = min(t, CHUNK)
    nc = t // lc
    mask = jnp.tril(jnp.ones((lc, lc), dtype=bool))
    ws = jnp.where(mask[None], w_s[:, :lc, :lc], jnp.zeros((), w_s.dtype))
    vc = v_n.reshape(bsz, nc, lc, N_GMLP_HEADS, HEAD_DIM)
    s = jnp.einsum("hij,bnjhd->bnihd", ws, vc) + b_s[:, :lc].T[None, None, :, :, None]
    return u * s.reshape(bsz, t, W_GMLP), v_n


def multiscale_pool(z, prefix, n_valid, pool_w, pool_scale):
    bsz, t, _ = z.shape
    ext = jnp.concatenate([prefix, z], axis=1)
    cs = jnp.cumsum(ext.astype(jnp.float32), axis=1)
    cs = jnp.concatenate([jnp.zeros((bsz, 1, W_POOL), jnp.float32), cs], axis=1)
    p = POOL_BUF
    pos = jnp.arange(t)
    pooled = []
    for g, w in enumerate(POOL_WINDOWS):
        lo, hi = g * POOL_GROUP_DIM, (g + 1) * POOL_GROUP_DIM
        s = cs[:, p + 1:p + t + 1, lo:hi] - cs[:, p + 1 - w:p + t + 1 - w, lo:hi]
        count = jnp.minimum(w, pos + 1 + n_valid).astype(jnp.float32)
        pooled.append(s / count[None, :, None])
    pooled = jnp.concatenate(pooled, axis=-1)
    d = (pooled - z.astype(jnp.float32)).astype(z.dtype)
    y = jnp.einsum("btgc,gcd->btgd", d.reshape(bsz, t, N_POOL_GROUPS, POOL_GROUP_DIM), pool_w)
    return y.reshape(bsz, t, W_POOL) * pool_scale, ext[:, -POOL_BUF:]


def mixer_block(h, conv_prefix, pool_prefix, n_valid, w_in, conv_w, sgu_g, sgu_b, w_s, b_s,
                pool_w, pool_scale, w_out):
    proj = jnp.einsum("btd,de->bte", h, w_in)
    cuts = [W_CONV, 2 * W_CONV, 3 * W_CONV, 3 * W_CONV + W_GMLP, 3 * W_CONV + 2 * W_GMLP]
    a_b, a_c, a_x, g_u, g_v, p_x = jnp.split(proj, cuts, axis=-1)
    conv_out, new_conv = short_conv(a_c * a_x, conv_prefix, conv_w)
    y_a = a_b * conv_out
    y_b, v_rows = chunk_sgu(g_u, g_v, sgu_g, sgu_b, w_s, b_s)
    y_c, new_pool = multiscale_pool(p_x, pool_prefix, n_valid, pool_w, pool_scale)
    mix = jnp.concatenate([y_a, y_b, y_c], axis=-1)
    return jnp.einsum("bte,ed->btd", mix, w_out), new_conv, new_pool, v_rows


def decoder_layer(x, c, conv_prefix, pool_prefix, n_valid, w_ada, b_ada, w_in, conv_w, sgu_g,
                  sgu_b, w_s, b_s, pool_w, pool_scale, w_out, ln1_g, ln1_b, w_up, w_down,
                  ln2_g, ln2_b):
    mod = jnp.einsum("bd,de->be", jax.nn.silu(c), w_ada) + b_ada
    sh1, sc1, g1, sh2, sc2, g2 = jnp.split(mod[:, None, :], 6, axis=-1)
    h = x * (1.0 + sc1) + sh1
    mix, new_conv, new_pool, v_rows = mixer_block(h, conv_prefix, pool_prefix, n_valid, w_in,
                                                  conv_w, sgu_g, sgu_b, w_s, b_s, pool_w,
                                                  pool_scale, w_out)
    x = layer_norm(DEEPNORM_ALPHA * x + g1 * mix, ln1_g, ln1_b)
    h2 = x * (1.0 + sc2) + sh2
    f = jnp.einsum("btf,fd->btd", jnp.square(jax.nn.relu(jnp.einsum("btd,df->btf", h2, w_up))), w_down)
    x = layer_norm(DEEPNORM_ALPHA * x + g2 * f, ln2_g, ln2_b)
    return x, new_conv, new_pool, v_rows


def setup_inputs(seed: int = 0) -> dict:
    key = jax.random.key(seed)
    ks = jax.random.split(key, 24)

    def nrm(k, shape, scale=1.0):
        return jax.random.normal(k, shape, jnp.float32) * scale

    return {
        "x_prompt": nrm(ks[0], (BATCH, SEQ, D_MODEL)),
        "x_sample": nrm(ks[1], (DEC_BATCH, DEC_SEQ, D_MODEL)),
        "c_prompt": nrm(ks[2], (BATCH, D_MODEL)),
        "c_sample": nrm(ks[3], (DEC_BATCH, D_MODEL)),
        "state_conv": nrm(ks[4], (DEPTH, DEC_BATCH, CONV_BUF, W_CONV)),
        "state_pool": nrm(ks[5], (DEPTH, DEC_BATCH, POOL_BUF, W_POOL)),
        "w_ada": nrm(ks[6], (DEPTH, D_MODEL, 6 * D_MODEL), 0.5 * D_MODEL ** -0.5),
        "b_ada": nrm(ks[7], (DEPTH, 6 * D_MODEL), 0.01),
        "w_in": nrm(ks[8], (DEPTH, D_MODEL, D_IN_PROJ), D_MODEL ** -0.5),
        "conv_w": nrm(ks[9], (DEPTH, CONV_WIDTH, W_CONV), CONV_WIDTH ** -0.5),
        "sgu_g": 1.0 + nrm(ks[10], (DEPTH, W_GMLP), 0.1),
        "sgu_b": nrm(ks[11], (DEPTH, W_GMLP), 0.01),
        "w_s": nrm(ks[12], (DEPTH, N_GMLP_HEADS, CHUNK, CHUNK), CHUNK ** -0.5),
        "b_s": 1.0 + nrm(ks[13], (DEPTH, N_GMLP_HEADS, CHUNK), 0.1),
        "pool_w": nrm(ks[14], (DEPTH, N_POOL_GROUPS, POOL_GROUP_DIM, POOL_GROUP_DIM), POOL_GROUP_DIM ** -0.5),
        "pool_scale": 1.0 + nrm(ks[15], (DEPTH, W_POOL), 0.1),
        "w_out": nrm(ks[16], (DEPTH, D_MIX, D_MODEL), DEEPNORM_BETA * D_MIX ** -0.5),
        "ln1_g": 1.0 + nrm(ks[17], (DEPTH, D_MODEL), 0.1),
        "ln1_b": nrm(ks[18], (DEPTH, D_MODEL), 0.01),
        "w_up": nrm(ks[19], (DEPTH, D_MODEL, D_FF), D_MODEL ** -0.5),
        "w_down": nrm(ks[20], (DEPTH, D_FF, D_MODEL), DEEPNORM_BETA * D_FF ** -0.5),
        "ln2_g": 1.0 + nrm(ks[21], (DEPTH, D_MODEL), 0.1),
        "ln2_b": nrm(ks[22], (DEPTH, D_MODEL), 0.01),
    }


def reference(x_prompt, x_sample, c_prompt, c_sample, state_conv, state_pool, w_ada, b_ada, w_in,
              conv_w, sgu_g, sgu_b, w_s, b_s, pool_w, pool_scale, w_out, ln1_g, ln1_b, w_up,
              w_down, ln2_g, ln2_b):
    bp = x_prompt.shape[0]
    xp, xs = x_prompt, x_sample
    conv_p, pool_p, conv_s, pool_s, v_s = [], [], [], [], []
    for l in range(DEPTH):
        params = (w_ada[l], b_ada[l], w_in[l], conv_w[l], sgu_g[l], sgu_b[l], w_s[l], b_s[l],
                  pool_w[l], pool_scale[l], w_out[l], ln1_g[l], ln1_b[l], w_up[l], w_down[l],
                  ln2_g[l], ln2_b[l])
        zc = jnp.zeros((bp, CONV_BUF, W_CONV), xp.dtype)
        zp = jnp.zeros((bp, POOL_BUF, W_POOL), xp.dtype)
        xp, nc_p, np_p, _ = decoder_layer(xp, c_prompt, zc, zp, 0, *params)
        xs, nc_s, np_s, v_rows = decoder_layer(xs, c_sample, state_conv[l], state_pool[l], POOL_BUF, *params)
        conv_p.append(nc_p)
        pool_p.append(np_p)
        conv_s.append(nc_s)
        pool_s.append(np_s)
        v_s.append(v_rows)
    new_state_conv_prompt = jnp.stack(conv_p)
    new_state_pool_prompt = jnp.stack(pool_p)
    new_state_conv_sample = jnp.stack(conv_s)
    new_state_pool_sample = jnp.stack(pool_s)
    new_state_gmlp_v_sample = jnp.stack(v_s)
    return (xp, xs, new_state_conv_prompt, new_state_pool_prompt, new_state_conv_sample,
            new_state_pool_sample, new_state_gmlp_v_sample)
```

```cpp
#include <hip/hip_runtime.h>
#include <cstdio>
#include <cstdint>
namespace pg8 {
#define PG8_LAS __attribute__((address_space(3)))
typedef unsigned short bf16_t;
typedef short bf16x8 __attribute__((ext_vector_type(8)));
typedef float f32x4 __attribute__((ext_vector_type(4)));
typedef unsigned u32x4 __attribute__((ext_vector_type(4)));
constexpr int BM = 256, BK = 64, HALF = 128, HTB = HALF * BK * 2  , STAGE_BYTES = 8 * HTB, NXCD = 8, WGM = 8;

__host__ __device__ __forceinline__ int lds_byte(int r, int c) { const int st = (r >> 4) * 2 + (c >> 5), rr = r & 15, cc = c & 31, ob = rr * 64 + cc * 2; return st * 1024 + (ob ^ (((ob >> 9) & 1) << 5)); }
__host__ __device__ __forceinline__ void stage_rc(int b, int& R, int& C) { const int st = b / 1024, sb = b % 1024, swz = sb ^ (((sb >> 9) & 1) << 5); R = (st >> 1) * 16 + swz / 64; C = (st & 1) * 32 + (swz % 64) / 2; }
__host__ __device__ __forceinline__ int perm32(int rho) { const int n = rho >> 4, i = rho & 15; return 8 * (i >> 2) + 4 * n + (i & 3); }

struct Unit { int pm, pn; };
struct Gemm { const bf16_t* A; const bf16_t* Bt; int M, N, K; };

struct StaticOrder {
    int nM, nN, nwg, G, c;
    __host__ __device__ void init(int M, int N, int G_, int c_) { nM = M / BM; nN = N / BM; nwg = nM * nN; G = G_; c = c_; }
    __host__ __device__ bool next(int i, Unit& u) const {
        const long L = (long)i * G + c; if (L >= nwg) return false;
        int wgid = (int)L; { const int q = nwg / NXCD, r = nwg % NXCD, xcd = wgid % NXCD, off = wgid / NXCD; wgid = (xcd < r ? xcd * (q + 1) : r * (q + 1) + (xcd - r) * q) + off; }
        const int nig = WGM * nN, gid = wgid / nig, fm = gid * WGM, gsz = (nM - fm) < WGM ? (nM - fm) : WGM;
        u.pm = fm + ((wgid % nig) % gsz); u.pn = (wgid % nig) / gsz; return true;
    }
    __device__ __forceinline__ void a_ready(const Unit&) const {}
    __device__ __forceinline__ void done(const Unit&) const {}
};

__device__ __forceinline__ unsigned cvt_pk_bf16(float lo, float hi) { unsigned r; asm volatile("v_cvt_pk_bf16_f32 %0, %1, %2" : "=v"(r) : "v"(lo), "v"(hi)); return r; }
typedef float f32x2 __attribute__((ext_vector_type(2)));
__device__ __forceinline__ f32x2 gelu_pk(f32x2 v) {
    const f32x2 av = __builtin_elementwise_abs(v), d = av * 0.2316418882f + 1.0f;
    f32x2 t; t.x = __builtin_amdgcn_rcpf(d.x); t.y = __builtin_amdgcn_rcpf(d.y);
    f32x2 q = t * 0.5307027145f + (-0.7265760135f); q = q * t + 0.7107068705f; q = q * t + (-0.142248368f); q = q * t + 0.127414796f; q = q * t;
    const f32x2 s = (v * v) * (-0.72134752044f);
    f32x2 e; e.x = __builtin_amdgcn_exp2f(s.x); e.y = __builtin_amdgcn_exp2f(s.y);
    const f32x2 m = v * (q * e), r = v - m;
    f32x2 o; o.x = v.x < 0.f ? m.x : r.x; o.y = v.y < 0.f ? m.y : r.y; return o;
}

struct EpiF32 {
    static constexpr bool PERM = false, AFTER_DRAIN = false;
    float* C; int ldc; const float* bias;
    __device__ __forceinline__ void operator()(const f32x4 (&acc)[2][2][4][2], const Unit& u, int wr, int wc, int fr, int fq) const {
        const int row0 = u.pm * BM + wr * 64 + fr, col0 = u.pn * BM + wc * 32 + 4 * fq;
        f32x4 bv[2][2];
#pragma unroll
        for (int bj = 0; bj < 2; ++bj)
#pragma unroll
            for (int n = 0; n < 2; ++n) bv[bj][n] = bias ? *(const f32x4*)(bias + col0 + bj * HALF + n * 16) : (f32x4){0.f, 0.f, 0.f, 0.f};
#pragma unroll
        for (int ai = 0; ai < 2; ++ai)
#pragma unroll
            for (int m = 0; m < 4; ++m) { float* rowp = C + (size_t)(row0 + ai * HALF + m * 16) * ldc + col0;
#pragma unroll
                for (int bj = 0; bj < 2; ++bj)
#pragma unroll
                    for (int n = 0; n < 2; ++n) *(f32x4*)(rowp + bj * HALF + n * 16) = acc[ai][bj][m][n] + bv[bj][n]; }
    }
};
template <int ACT  > struct EpiBf16 {
    static constexpr bool PERM = true, AFTER_DRAIN = false; static_assert(ACT == 0 || ACT == 1 || ACT == 2, "EpiBf16: ACT is 0 (none), 1 (gelu_pk) or 2 (squared relu)");
    bf16_t* O; int ldc; const float* bias; int split_cols; size_t split_stride; float scale0;
    __device__ __forceinline__ void operator()(const f32x4 (&acc)[2][2][4][2], const Unit& u, int wr, int wc, int fr, int fq) const {
        const int row0 = u.pm * BM + wr * 64 + fr; int colt = u.pn * BM; bf16_t* base = O;
        float sc = 1.f; if (split_cols) { const int t = colt / split_cols; base += (size_t)t * split_stride; colt -= t * split_cols; if (t == 0) sc = scale0; }
        const int col0 = colt + wc * 32 + 8 * fq, bcol0 = u.pn * BM + wc * 32 + 8 * fq;
        f32x4 bv[2][2];
#pragma unroll
        for (int bj = 0; bj < 2; ++bj)
#pragma unroll
            for (int n = 0; n < 2; ++n) bv[bj][n] = bias ? *(const f32x4*)(bias + bcol0 + bj * HALF + 4 * n) : (f32x4){0.f, 0.f, 0.f, 0.f};
#pragma unroll
        for (int ai = 0; ai < 2; ++ai)
#pragma unroll
            for (int m = 0; m < 4; ++m) { bf16_t* rowp = base + (size_t)(row0 + ai * HALF + m * 16) * ldc + col0;
#pragma unroll
                for (int bj = 0; bj < 2; ++bj) { f32x4 v0 = acc[ai][bj][m][0] + bv[bj][0], v1 = acc[ai][bj][m][1] + bv[bj][1];
                    if (ACT == 1) { f32x2 a = gelu_pk((f32x2){v0[0], v0[1]}), b = gelu_pk((f32x2){v0[2], v0[3]}), c = gelu_pk((f32x2){v1[0], v1[1]}), d = gelu_pk((f32x2){v1[2], v1[3]});
                        v0 = (f32x4){a.x, a.y, b.x, b.y}; v1 = (f32x4){c.x, c.y, d.x, d.y}; }
                    if (ACT == 2) { v0 = __builtin_elementwise_max(v0, (f32x4){0.f, 0.f, 0.f, 0.f}); v1 = __builtin_elementwise_max(v1, (f32x4){0.f, 0.f, 0.f, 0.f}); v0 = v0 * v0; v1 = v1 * v1; }
                    v0 = v0 * sc; v1 = v1 * sc; u32x4 w; w.x = cvt_pk_bf16(v0[0], v0[1]); w.y = cvt_pk_bf16(v0[2], v0[3]); w.z = cvt_pk_bf16(v1[0], v1[1]); w.w = cvt_pk_bf16(v1[2], v1[3]);
                    *(u32x4*)(rowp + bj * HALF) = w; } }
    }
};

struct PanelStats {
    unsigned* xbuf;
    unsigned* cnt;
    unsigned* tmo;
    int ntn; float eps;
    unsigned code;
    __device__ __forceinline__ bool run(const f32x4 (&v)[2][2][4][2], const Unit& u, int wr, int wc, int fr, int fq, PG8_LAS unsigned char* lds, int wid, int lane) const {
        typedef float f32x2v __attribute__((ext_vector_type(2)));
        PG8_LAS f32x2v* P = (PG8_LAS f32x2v*)lds;
        PG8_LAS f32x2v* S = (PG8_LAS f32x2v*)(lds + 8192);
        PG8_LAS unsigned* flag = (PG8_LAS unsigned*)(lds + 8192 + 2048);
#pragma unroll
        for (int ai = 0; ai < 2; ++ai)
#pragma unroll
            for (int m = 0; m < 4; ++m) {
                float s = 0.f;
#pragma unroll
                for (int bj = 0; bj < 2; ++bj)
#pragma unroll
                    for (int n = 0; n < 2; ++n) { const f32x4 x = v[ai][bj][m][n]; s += (x[0] + x[1]) + (x[2] + x[3]); }
                s += __shfl_xor(s, 16); s += __shfl_xor(s, 32);
                const float mw = s * (1.0f / 64.0f); float q = 0.f;
#pragma unroll
                for (int bj = 0; bj < 2; ++bj)
#pragma unroll
                    for (int n = 0; n < 2; ++n) { const f32x4 d = v[ai][bj][m][n] - mw; q += (d[0] * d[0] + d[1] * d[1]) + (d[2] * d[2] + d[3] * d[3]); }
                q += __shfl_xor(q, 16); q += __shfl_xor(q, 32);
                if (fq == 0) P[(ai * HALF + wr * 64 + m * 16 + fr) * 4 + wc] = (f32x2v){mw, q};
            }
        asm volatile("s_waitcnt lgkmcnt(0)" ::: "memory"); __builtin_amdgcn_s_barrier(); asm volatile("" ::: "memory");
#if defined(BROKEN_EXCHANGE_NO_WAIT)
#warning BROKEN CONTROL BUILD: the row-statistics exchange does not wait; results are wrong by design
        if (blockIdx.x >= 64) { const long long t0_ = clock64(); while (clock64() - t0_ < 60000) __builtin_amdgcn_s_sleep(8); }
#endif
        const int row = wid * 32 + (lane & 31);
        if (lane < 32) {
            const f32x2v a = P[row * 4 + 0], b = P[row * 4 + 1], c = P[row * 4 + 2], d = P[row * 4 + 3];
            const float mt = (a.x + b.x + c.x + d.x) * 0.25f;
            const float da = a.x - mt, db = b.x - mt, dc = c.x - mt, dd = d.x - mt;
            const float m2 = (a.y + b.y) + (c.y + d.y) + 64.0f * ((da * da + db * db) + (dc * dc + dd * dd));
            unsigned long long* slot = (unsigned long long*)xbuf + ((size_t)(u.pm * BM + row) * 4 + u.pn);
            __hip_atomic_store(slot, ((unsigned long long)__float_as_uint(m2) << 32) | __float_as_uint(mt), __ATOMIC_RELAXED, __HIP_MEMORY_SCOPE_AGENT);
        }
        asm volatile("s_waitcnt vmcnt(0)" ::: "memory");
        if (lane == 0) __hip_atomic_fetch_add(cnt + 64 * u.pm, 1u, __ATOMIC_RELAXED, __HIP_MEMORY_SCOPE_AGENT);
        if (wid == 0) {
            bool dead = false; const unsigned long long t0 = __builtin_amdgcn_s_memrealtime(); const unsigned want = 8u * (unsigned)ntn;
            for (;;) {
#if defined(BROKEN_EXCHANGE_NO_WAIT)
                break;
#endif
                if ((unsigned)__builtin_amdgcn_readfirstlane(__hip_atomic_load(cnt + 64 * u.pm, __ATOMIC_RELAXED, __HIP_MEMORY_SCOPE_AGENT)) >= want) break;
                if (__builtin_amdgcn_s_memrealtime() - t0 > 2000000ull) {
                    if (lane == 0) { unsigned expect = 0u; __hip_atomic_compare_exchange_strong(tmo + 1, &expect, code | (unsigned)(u.pm & 0xff), __ATOMIC_RELAXED, __ATOMIC_RELAXED, __HIP_MEMORY_SCOPE_AGENT);
                                     __hip_atomic_store(tmo, 1u, __ATOMIC_RELAXED, __HIP_MEMORY_SCOPE_AGENT); }
                    dead = true; break; }
                __builtin_amdgcn_s_sleep(2);
            }
            __builtin_amdgcn_fence(__ATOMIC_ACQUIRE, "agent");
            if (lane == 0) flag[0] = dead ? 1u : 0u;
        }
        asm volatile("s_waitcnt vmcnt(0) lgkmcnt(0)" ::: "memory"); __builtin_amdgcn_s_barrier(); asm volatile("" ::: "memory");
        const bool bad = flag[0] != 0u;
        if (lane < 32) {
            const unsigned long long* slot = (const unsigned long long*)xbuf + (size_t)(u.pm * BM + row) * 4; float mt[4], m2[4]; float ms = 0.f;
#pragma unroll
            for (int t = 0; t < 4; ++t) { if (t < ntn) { const unsigned long long w = __hip_atomic_load(slot + t, __ATOMIC_RELAXED, __HIP_MEMORY_SCOPE_AGENT); mt[t] = __uint_as_float((unsigned)w); m2[t] = __uint_as_float((unsigned)(w >> 32)); } else { mt[t] = 0.f; m2[t] = 0.f; } ms += mt[t]; }
            const float mean = ms / (float)ntn; float q = 0.f;
#pragma unroll
            for (int t = 0; t < 4; ++t) if (t < ntn) { const float dm = mt[t] - mean; q += m2[t] + 256.0f * dm * dm; }
            S[row] = (f32x2v){mean, 1.0f / sqrtf(q / (256.0f * (float)ntn) + eps)};
        }
        asm volatile("s_waitcnt lgkmcnt(0)" ::: "memory"); __builtin_amdgcn_s_barrier(); asm volatile("" ::: "memory");
        return bad;
    }
};
struct EpiLnRes {
    static constexpr bool PERM = false, AFTER_DRAIN = true;
    const float* base; float* out; int ldc; const float* bias; PanelStats st; unsigned poison;
    __device__ __forceinline__ void fused(f32x4 (&acc)[2][2][4][2], const Unit& u, int wr, int wc, int fr, int fq, PG8_LAS unsigned char* lds, int wid, int lane) const {
        typedef float f32x2v __attribute__((ext_vector_type(2)));
        const PG8_LAS f32x2v* S = (const PG8_LAS f32x2v*)(lds + 8192);
        const int col0 = u.pn * BM + wc * 32 + 4 * fq;
#pragma unroll
        for (int bj = 0; bj < 2; ++bj)
#pragma unroll
            for (int n = 0; n < 2; ++n) { const f32x4 bv = bias ? *(const f32x4*)(bias + col0 + bj * HALF + n * 16) : (f32x4){0.f, 0.f, 0.f, 0.f};
#pragma unroll
                for (int ai = 0; ai < 2; ++ai)
#pragma unroll
                    for (int m = 0; m < 4; ++m) acc[ai][bj][m][n] += bv; }
        f32x4 pre[4][2][2];
#pragma unroll
        for (int m = 0; m < 4; ++m) { const size_t off = (size_t)(u.pm * BM + wr * 64 + m * 16 + fr) * ldc + col0;
#pragma unroll
            for (int bj = 0; bj < 2; ++bj)
#pragma unroll
                for (int n = 0; n < 2; ++n) pre[m][bj][n] = *(const f32x4*)(base + off + bj * HALF + n * 16); }
        const bool bad = st.run(acc, u, wr, wc, fr, fq, lds, wid, lane) || poison != 0u;
        const float qnan = __builtin_nanf("");
#pragma unroll
        for (int ai = 0; ai < 2; ++ai)
#pragma unroll
            for (int m = 0; m < 4; ++m) { const int r = ai * HALF + wr * 64 + m * 16 + fr; const f32x2v sr = S[r]; const size_t off = (size_t)(u.pm * BM + r) * ldc + col0;
#pragma unroll
                for (int bj = 0; bj < 2; ++bj)
#pragma unroll
                    for (int n = 0; n < 2; ++n) { const f32x4 bs = ai == 0 ? pre[m][bj][n] : *(const f32x4*)(base + off + bj * HALF + n * 16); f32x4 o = bs + (acc[ai][bj][m][n] - sr.x) * sr.y;
                        if (bad) o = (f32x4){qnan, qnan, qnan, qnan}; *(f32x4*)(out + off + bj * HALF + n * 16) = o; }
                if (m & 1) asm volatile("" ::: "memory"); }
    }
};
struct EpiLnResLn {
    static constexpr bool PERM = false, AFTER_DRAIN = true;
    const float* base; float* out; bf16_t* xn; int ldc; const float* bias; PanelStats st1, st2; unsigned poison;
    __device__ __forceinline__ void fused(f32x4 (&acc)[2][2][4][2], const Unit& u, int wr, int wc, int fr, int fq, PG8_LAS unsigned char* lds, int wid, int lane) const {
        typedef float f32x2v __attribute__((ext_vector_type(2))); typedef unsigned u32x2v __attribute__((ext_vector_type(2)));
        const PG8_LAS f32x2v* S = (const PG8_LAS f32x2v*)(lds + 8192);
        const int col0 = u.pn * BM + wc * 32 + 4 * fq;
#pragma unroll
        for (int bj = 0; bj < 2; ++bj)
#pragma unroll
            for (int n = 0; n < 2; ++n) { const f32x4 bv = bias ? *(const f32x4*)(bias + col0 + bj * HALF + n * 16) : (f32x4){0.f, 0.f, 0.f, 0.f};
#pragma unroll
                for (int ai = 0; ai < 2; ++ai)
#pragma unroll
                    for (int m = 0; m < 4; ++m) acc[ai][bj][m][n] += bv; }
        bool bad = st1.run(acc, u, wr, wc, fr, fq, lds, wid, lane) || poison != 0u;
        const float qnan = __builtin_nanf("");
#pragma unroll
        for (int ai = 0; ai < 2; ++ai)
#pragma unroll
            for (int m = 0; m < 4; ++m) { const int r = ai * HALF + wr * 64 + m * 16 + fr; const f32x2v sr = S[r]; const size_t off = (size_t)(u.pm * BM + r) * ldc + col0;
#pragma unroll
                for (int bj = 0; bj < 2; ++bj)
#pragma unroll
                    for (int n = 0; n < 2; ++n) { const f32x4 bs = *(const f32x4*)(base + off + bj * HALF + n * 16); acc[ai][bj][m][n] = bs + (acc[ai][bj][m][n] - sr.x) * sr.y; }
                asm volatile("" : "+v"(acc[ai][0][m][0]), "+v"(acc[ai][0][m][1]), "+v"(acc[ai][1][m][0]), "+v"(acc[ai][1][m][1]));
                if (m & 1) asm volatile("" ::: "memory"); }
        const bool bad1 = bad;
        bad = st2.run(acc, u, wr, wc, fr, fq, lds, wid, lane) || bad;
#pragma unroll
        for (int ai = 0; ai < 2; ++ai)
#pragma unroll
            for (int m = 0; m < 4; ++m) { const int r = ai * HALF + wr * 64 + m * 16 + fr; const f32x2v sr = S[r]; const size_t off = (size_t)(u.pm * BM + r) * ldc + col0;
#pragma unroll
                for (int bj = 0; bj < 2; ++bj)
#pragma unroll
                    for (int n = 0; n < 2; ++n) { const f32x4 x1 = acc[ai][bj][m][n]; *(f32x4*)(out + off + bj * HALF + n * 16) = bad1 ? (f32x4){qnan, qnan, qnan, qnan} : x1;
                        const f32x4 o = (x1 - sr.x) * sr.y; u32x2v w; w.x = cvt_pk_bf16(o[0], o[1]); w.y = cvt_pk_bf16(o[2], o[3]);
                        if (bad) { w.x = 0x7fc07fc0u; w.y = 0x7fc07fc0u; } *(u32x2v*)(xn + off + bj * HALF + n * 16) = w; }
                asm volatile("" ::: "memory"); }
    }
};


struct EpiRes {
    static constexpr bool PERM = false, AFTER_DRAIN = false;
    const float* xp; const float* xs; float* out; const float* gate; float alpha;
    __device__ __forceinline__ void operator()(const f32x4 (&acc)[2][2][4][2], const Unit& u, int wr, int wc, int fr, int fq) const {
        const int row0 = u.pm * BM + wr * 64 + fr, col0 = u.pn * BM + wc * 32 + 4 * fq; const bool samp = u.pm >= 64;
#pragma unroll
        for (int ai = 0; ai < 2; ++ai)
#pragma unroll
            for (int m = 0; m < 4; ++m) { const int r = row0 + ai * HALF + m * 16;
                const float* xrow = samp ? xs + (size_t)(r - 16384) * 1024 : xp + (size_t)r * 1024;
                const int mr = samp ? 8 + ((r - 16384) >> 3) : (r >> 11);
                const float* grow = gate + (size_t)mr * 12288; float* orow = out + (size_t)r * 1024;
#pragma unroll
                for (int bj = 0; bj < 2; ++bj)
#pragma unroll
                    for (int n = 0; n < 2; ++n) { const int c = col0 + bj * HALF + n * 16; const f32x4 xv = *(const f32x4*)(xrow + c), gv = *(const f32x4*)(grow + c);
                        *(f32x4*)(orow + c) = xv * alpha + gv * acc[ai][bj][m][n]; }
                asm volatile("" ::: "memory"); }
    }
};
template <class Epi, class Sched, bool ALIGN_EPI = false, bool SP2 = false>
__device__ __forceinline__ void gemm_phase(PG8_LAS unsigned char* lds, const Gemm g, const Sched& S, const Epi& E) {
    int tid_ = threadIdx.x; asm volatile("" : "+v"(tid_));
    const int tid = tid_, wid = __builtin_amdgcn_readfirstlane(tid >> 6), lane = tid & 63, wr = wid >> 2, wc = wid & 3, fr = lane & 15, fq = lane >> 4;
    const int K = g.K, nt = K / BK;
    unsigned voffA[2], voffB[2];
#pragma unroll
    for (int i = 0; i < 2; ++i) { int R, C; stage_rc(tid * 16 + i * 8192, R, C); const int Rb = Epi::PERM ? ((R & ~31) + perm32(R & 31)) : R;
        voffA[i] = (unsigned)(R * K + C) * 2u; voffB[i] = (unsigned)(Rb * K + C) * 2u; }
    const size_t kstep = (size_t)(BK * 2);
    const size_t hstep = (size_t)HALF * K * 2;
    const size_t tstep = 2 * hstep;
    const unsigned ldsw = (unsigned)wid * 1024u;
    const int aoff = lds_byte(wr * 64 + fr, fq * 8), boff = lds_byte(wc * 32 + fr, fq * 8);
#define PG8_SA(b, h) (((b) * 2 + (h)) * HTB)
#define PG8_SB(b, h) ((4 + (b) * 2 + (h)) * HTB)
#define PG8_STAGE(bufoff, gbase, voff) do { _Pragma("unroll") for (int _i = 0; _i < 2; ++_i) \
        __builtin_amdgcn_global_load_lds((const unsigned*)((const char*)(gbase) + (voff)[_i]), (PG8_LAS unsigned*)(lds + (bufoff) + ldsw + _i * 8192), 16, 0, 0); } while (0)
#define PG8_LDA(dst, b, h) do { _Pragma("unroll") for (int m = 0; m < 4; ++m) _Pragma("unroll") for (int k = 0; k < 2; ++k) dst[m][k] = *(const PG8_LAS bf16x8*)(lds + PG8_SA(b, h) + aoff + m * 2048 + k * 1024); } while (0)
#define PG8_LDB(dst, b, h) do { _Pragma("unroll") for (int n = 0; n < 2; ++n) _Pragma("unroll") for (int k = 0; k < 2; ++k) dst[n][k] = *(const PG8_LAS bf16x8*)(lds + PG8_SB(b, h) + boff + n * 2048 + k * 1024); } while (0)
#define PG8_MMA(ai, bj, At, Bt) do { __builtin_amdgcn_s_setprio(1); _Pragma("unroll") for (int m = 0; m < 4; ++m) _Pragma("unroll") for (int n = 0; n < 2; ++n) _Pragma("unroll") for (int k = 0; k < 2; ++k) \
        acc[ai][bj][m][n] = __builtin_amdgcn_mfma_f32_16x16x32_bf16(Bt[n][k], At[m][k], acc[ai][bj][m][n], 0, 0, 0); __builtin_amdgcn_s_setprio(0); } while (0)
#define PG8_WAIT_V(n) asm volatile("s_waitcnt vmcnt(" #n ")" ::: "memory")
#define PG8_WAIT_L(n) asm volatile("s_waitcnt lgkmcnt(" #n ")" ::: "memory")
#define PG8_BAR __builtin_amdgcn_s_barrier()
#define PG8_SCHED __builtin_amdgcn_sched_barrier(0)
    Unit cur, nxt; int ui = 0;
    if (!S.next(0, cur)) return;
    f32x4 acc[2][2][4][2];
#pragma unroll
    for (int a = 0; a < 2; ++a)
#pragma unroll
        for (int b = 0; b < 2; ++b)
#pragma unroll
            for (int m = 0; m < 4; ++m)
#pragma unroll
                for (int n = 0; n < 2; ++n) acc[a][b][m][n] = (f32x4){0.f, 0.f, 0.f, 0.f};
    bf16x8 At[4][2], B0[2][2], B1[2][2];
    const char* cA = (const char*)g.A + (size_t)cur.pm * tstep; const char* cB = (const char*)g.Bt + (size_t)cur.pn * tstep;
    S.a_ready(cur);
    if constexpr (SP2) {
        PG8_STAGE(PG8_SB(0, 0), cB, voffB); PG8_STAGE(PG8_SB(0, 1), cB + hstep, voffB); PG8_STAGE(PG8_SA(0, 0), cA, voffA); PG8_STAGE(PG8_SA(0, 1), cA + hstep, voffA);
        if (wr == 1) PG8_BAR;
        PG8_WAIT_V(2); PG8_BAR;
        PG8_STAGE(PG8_SB(1, 0), cB + kstep, voffB); PG8_STAGE(PG8_SA(1, 0), cA + kstep, voffA); PG8_STAGE(PG8_SB(1, 1), cB + hstep + kstep, voffB);
        PG8_WAIT_V(6); PG8_BAR;
    } else {
        PG8_STAGE(PG8_SB(0, 0), cB, voffB); PG8_STAGE(PG8_SA(0, 0), cA, voffA); PG8_STAGE(PG8_SB(0, 1), cB + hstep, voffB); PG8_STAGE(PG8_SA(0, 1), cA + hstep, voffA);
        if (wr == 1) PG8_BAR;
        PG8_WAIT_V(4); PG8_BAR;
        PG8_STAGE(PG8_SB(1, 0), cB + kstep, voffB); PG8_STAGE(PG8_SA(1, 0), cA + kstep, voffA); PG8_STAGE(PG8_SB(1, 1), cB + hstep + kstep, voffB);
        PG8_WAIT_V(6); PG8_BAR;
    }
    for (;;) {
        const bool has_next = S.next(ui + 1, nxt);
        const char* nA = has_next ? (const char*)g.A + (size_t)nxt.pm * tstep : cA; const char* nB = has_next ? (const char*)g.Bt + (size_t)nxt.pn * tstep : cB;
        for (int t = 0; t < nt; t += 2) {
            const bool last = (t == nt - 2);
            const char* a1 = cA + (size_t)(t + 1) * kstep;
            const char* a2 = last ? nA : cA + (size_t)(t + 2) * kstep; const char* b2 = last ? nB : cB + (size_t)(t + 2) * kstep;
            const char* a3 = a2 + kstep; const char* b3 = b2 + kstep;
            if (last && has_next) S.a_ready(nxt);
            if constexpr (SP2) {
            PG8_LDB(B0, 0, 0); PG8_LDB(B1, 0, 1); PG8_SCHED; PG8_LDA(At, 0, 0); PG8_STAGE(PG8_SA(1, 1), a1 + hstep, voffA);
            PG8_WAIT_V(8); PG8_WAIT_L(0); PG8_BAR; PG8_MMA(0, 0, At, B0); PG8_MMA(0, 1, At, B1); PG8_BAR; PG8_SCHED;
            PG8_LDA(At, 0, 1); PG8_STAGE(PG8_SB(0, 0), b2, voffB); PG8_STAGE(PG8_SB(0, 1), b2 + hstep, voffB); PG8_STAGE(PG8_SA(0, 0), a2, voffA);
            PG8_WAIT_V(8); PG8_WAIT_L(0); PG8_BAR; PG8_MMA(1, 0, At, B0); PG8_MMA(1, 1, At, B1); PG8_BAR; PG8_SCHED;
            PG8_LDB(B0, 1, 0); PG8_LDB(B1, 1, 1); PG8_SCHED; PG8_LDA(At, 1, 0); PG8_STAGE(PG8_SA(0, 1), a2 + hstep, voffA);
            PG8_WAIT_V(8); PG8_WAIT_L(0); PG8_BAR; PG8_MMA(0, 0, At, B0); PG8_MMA(0, 1, At, B1); PG8_BAR; PG8_SCHED;
            PG8_LDA(At, 1, 1); PG8_STAGE(PG8_SB(1, 0), b3, voffB); PG8_STAGE(PG8_SB(1, 1), b3 + hstep, voffB); PG8_STAGE(PG8_SA(1, 0), a3, voffA);
            PG8_WAIT_V(8); PG8_WAIT_L(0); PG8_BAR; PG8_MMA(1, 0, At, B0); PG8_MMA(1, 1, At, B1); PG8_BAR; PG8_SCHED;
            } else {
            PG8_LDB(B0, 0, 0); PG8_SCHED; PG8_LDA(At, 0, 0); PG8_STAGE(PG8_SA(1, 1), a1 + hstep, voffA);
            PG8_WAIT_L(8); PG8_BAR; PG8_WAIT_L(0); PG8_MMA(0, 0, At, B0); PG8_BAR; PG8_SCHED;
            PG8_LDB(B1, 0, 1); PG8_STAGE(PG8_SB(0, 0), b2, voffB);
            PG8_BAR; PG8_WAIT_L(0); PG8_MMA(0, 1, At, B1); PG8_BAR;
            PG8_LDA(At, 0, 1); PG8_STAGE(PG8_SA(0, 0), a2, voffA);
            PG8_BAR; PG8_WAIT_L(0); PG8_MMA(1, 0, At, B0); PG8_BAR; PG8_SCHED;
            PG8_STAGE(PG8_SB(0, 1), b2 + hstep, voffB);
            PG8_WAIT_V(6); PG8_BAR; PG8_MMA(1, 1, At, B1); PG8_BAR;
            PG8_LDB(B0, 1, 0); PG8_SCHED; PG8_LDA(At, 1, 0); PG8_STAGE(PG8_SA(0, 1), a2 + hstep, voffA);
            PG8_WAIT_L(8); PG8_BAR; PG8_WAIT_L(0); PG8_MMA(0, 0, At, B0); PG8_BAR; PG8_SCHED;
            PG8_LDB(B1, 1, 1); PG8_STAGE(PG8_SB(1, 0), b3, voffB);
            PG8_BAR; PG8_WAIT_L(0); PG8_MMA(0, 1, At, B1); PG8_BAR;
            PG8_LDA(At, 1, 1); PG8_STAGE(PG8_SA(1, 0), a3, voffA);
            PG8_BAR; PG8_WAIT_L(0); PG8_MMA(1, 0, At, B0); PG8_BAR; PG8_SCHED;
            PG8_STAGE(PG8_SB(1, 1), b3 + hstep, voffB);
            PG8_WAIT_V(6); PG8_BAR; PG8_MMA(1, 1, At, B1); PG8_BAR;
            }
        }
        if constexpr (ALIGN_EPI) { if (wr == 0) PG8_BAR; }
        if constexpr (!Epi::AFTER_DRAIN) { E(acc, cur, wr, wc, fr, fq); S.done(cur); }
        if (!has_next) break;
#pragma unroll
        for (int a = 0; a < 2; ++a)
#pragma unroll
            for (int b = 0; b < 2; ++b)
#pragma unroll
                for (int m = 0; m < 4; ++m)
#pragma unroll
                    for (int n = 0; n < 2; ++n) acc[a][b][m][n] = (f32x4){0.f, 0.f, 0.f, 0.f};
        cur = nxt; cA = nA; cB = nB; ++ui;
        if constexpr (ALIGN_EPI) { if (wr == 1) PG8_BAR; }
    }
    PG8_WAIT_V(0);
    if constexpr (!ALIGN_EPI) { if (wr == 0) PG8_BAR; }
    PG8_BAR;
    if constexpr (Epi::AFTER_DRAIN) { E.fused(acc, cur, wr, wc, fr, fq, lds, wid, lane); S.done(cur); }
#undef PG8_SA
#undef PG8_SB
#undef PG8_STAGE
#undef PG8_LDA
#undef PG8_LDB
#undef PG8_MMA
#undef PG8_WAIT_V
#undef PG8_WAIT_L
#undef PG8_BAR
#undef PG8_SCHED
}
}


constexpr int NWAVES = 8;
constexpr int D = 1024, BP = 8, TP = 2048, BS = 128, TS = 8, MP = BP * TP, MS = BS * TS, M = MP + MS, NIN = 2048, FF = 4096, NL = 2;
constexpr int NMODROW = 256, NMOD = 6144, MODLD = NL * NMOD;
constexpr float LN_EPS = 1e-5f;
constexpr float DN_ALPHA = 1.41421356237309515f;
constexpr size_t O_YP = 0, O_YS = (size_t)MP * D, O_CP = O_YS + (size_t)MS * D, O_PP = O_CP + (size_t)NL * BP * 2 * 256, O_CS = O_PP + (size_t)NL * BP * 15 * 256,
                 O_PS = O_CS + (size_t)NL * BS * 2 * 256, O_VS = O_PS + (size_t)NL * BS * 15 * 256, O_END = O_VS + (size_t)NL * BS * TS * 512;
constexpr size_t MiB = 1u << 20;
constexpr size_t WS_CTL = 0, CTL_ZERO_BYTES = 1 * MiB;
constexpr size_t WS_WIN = 2 * MiB, WS_WOUT = 10 * MiB, WS_WUP = 14 * MiB, WS_WDN = 30 * MiB;
constexpr size_t WS_MOD = 46 * MiB, WS_X = 58 * MiB, WS_HA = 60 * MiB, WS_BIG = 94 * MiB;
constexpr size_t WS_PROJ = WS_BIG, WS_MIX = WS_BIG + 68 * MiB, WS_HID = WS_BIG;
constexpr size_t WS_WADA = WS_BIG, WS_AC = WS_BIG + 24 * MiB;
constexpr size_t WS_END = WS_BIG + 136 * MiB;
static_assert(WS_END <= 256 * MiB, "d_ws map");
constexpr int CW_TMO = 0, CW_CODE = 1, CW_BAR = 4096;

constexpr int RING_OFF = 0, RING_BYTES = 131072, LDSCTL_OFF = RING_BYTES, MISC_OFF = LDSCTL_OFF + 320, LDS_BYTES = 147456;

#define GAS __attribute__((address_space(1)))
#define LAS __attribute__((address_space(3)))
typedef unsigned short bf16;
typedef unsigned v4u __attribute__((ext_vector_type(4)));
typedef unsigned v2u __attribute__((ext_vector_type(2)));
typedef float f32x4 __attribute__((ext_vector_type(4)));
typedef GAS unsigned gu32;
#define RLX_AGENT __ATOMIC_RELAXED, __HIP_MEMORY_SCOPE_AGENT
#define LDS_WAIT() asm volatile("s_waitcnt lgkmcnt(0)" ::: "memory")
#define VM_WAIT() asm volatile("s_waitcnt vmcnt(0)" ::: "memory")
__device__ __forceinline__ unsigned f2bf(float f) { unsigned u = __builtin_bit_cast(unsigned, f); return (u + 0x7fffu + ((u >> 16) & 1u)) >> 16; }
__device__ __forceinline__ unsigned pk2(float lo, float hi) { return f2bf(lo) | (f2bf(hi) << 16); }
__device__ __forceinline__ float bflo(unsigned w) { return __builtin_bit_cast(float, w << 16); }
__device__ __forceinline__ float bfhi(unsigned w) { return __builtin_bit_cast(float, w & 0xffff0000u); }
__device__ __forceinline__ float bf1(bf16 h) { return __builtin_bit_cast(float, (unsigned)h << 16); }

#define XB_TMO      128
#define XB_XCNT(j)  (256  + 64 * (j))
#define XB_XSUB(j)  (1280 + 64 * (j))
#define XB_XGEN(j)  (2304 + 64 * (j))
#define XB_TOP      3328
#define XB_TOPGEN   3392
#define XCD_BAR_WORDS 3456
#define XB_SPIN_CAP (1u << 18)

__device__ __forceinline__ unsigned xb_ld(unsigned* p)              { return __hip_atomic_load(p, __ATOMIC_RELAXED, __HIP_MEMORY_SCOPE_AGENT); }
__device__ __forceinline__ unsigned xb_add(unsigned* p, unsigned v) { return __hip_atomic_fetch_add(p, v, __ATOMIC_RELAXED, __HIP_MEMORY_SCOPE_AGENT); }
__device__ __forceinline__ unsigned xb_xcc_id() { return (unsigned)__builtin_amdgcn_s_getreg((3 << 11) | 20) & 0xFu; }
#define XB_SPIN(cond, bar) do { unsigned _sp = 0; while (cond) { __builtin_amdgcn_s_sleep(1); \
    if ((++_sp & 255u) == 0u) { if (xb_ld(&(bar)[XB_TMO])) break; if (_sp > XB_SPIN_CAP) { atomicAdd(&(bar)[XB_TMO], 1u); break; } } } } while (0)

struct XcdBarrier {
    unsigned* bar; unsigned x;
    volatile LAS unsigned* st;
};

__device__ __forceinline__ XcdBarrier xcd_barrier_post(unsigned* bar, volatile LAS unsigned* st) {
    XcdBarrier b; b.bar = bar; b.x = xb_xcc_id(); b.st = st;
    if (threadIdx.x == 0) (void)xb_add(&bar[XB_XCNT(b.x)], 1u);
    return b;
}
__device__ __forceinline__ void xcd_barrier_complete(unsigned* bar, unsigned x, unsigned& nloc, unsigned& nx) {
    const unsigned G = gridDim.x * gridDim.y * gridDim.z;
    unsigned sum, cnt, mine, sp = 0u;
    for (;;) {
        sum = 0u; cnt = 0u; mine = 0u;
#pragma unroll
        for (unsigned j = 0; j < 16; ++j) { const unsigned c = xb_ld(&bar[XB_XCNT(j)]); sum += c; cnt += (c > 0u) ? 1u : 0u; mine = (j == x) ? c : mine; }
        if (sum == G) break;
        __builtin_amdgcn_s_sleep(1);
        if ((++sp & 255u) == 0u) { if (xb_ld(&bar[XB_TMO])) break; if (sp > XB_SPIN_CAP) { atomicAdd(&bar[XB_TMO], 1u); break; } }
    }
    nloc = mine > 0u ? mine : 1u; nx = cnt > 0u ? cnt : 1u;
}

__device__ __forceinline__ void xcd_barrier(const XcdBarrier& b) {
    asm volatile("s_waitcnt vmcnt(0)" ::: "memory");
    __syncthreads();
    if (threadIdx.x == 0) {
        unsigned* bar = b.bar;
        __builtin_amdgcn_s_waitcnt(0);
        unsigned nloc = b.st[0], nx = b.st[1];
        if (nloc == 0u) { xcd_barrier_complete(bar, b.x, nloc, nx); b.st[0] = nloc; b.st[1] = nx; }
        const unsigned old = xb_add(&bar[XB_XSUB(b.x)], 1u);
        const unsigned gen = old / nloc;
        if (old + 1u == (gen + 1u) * nloc) {
            __builtin_amdgcn_fence(__ATOMIC_RELEASE, "agent");
            asm volatile("s_waitcnt vmcnt(0)" ::: "memory");
            const unsigned og = xb_add(&bar[XB_TOP], 1u);
            const unsigned tg = og / nx;
            if (og + 1u == (tg + 1u) * nx) xb_add(&bar[XB_TOPGEN], 1u);
            else XB_SPIN(xb_ld(&bar[XB_TOPGEN]) == tg, bar);
            __builtin_amdgcn_fence(__ATOMIC_ACQUIRE, "agent");
            xb_add(&bar[XB_XGEN(b.x)], 1u);
            asm volatile("s_waitcnt vmcnt(0)" ::: "memory");
        } else {
            XB_SPIN(xb_ld(&bar[XB_XGEN(b.x)]) == gen, bar);
            __builtin_amdgcn_fence(__ATOMIC_ACQUIRE, "agent");
            asm volatile("s_waitcnt vmcnt(0)" ::: "memory");
        }
    }
    __syncthreads();
}


struct Args { const float* in[23]; float* out; unsigned char* ws; int ph_lo, ph_hi; };
struct Frame {
    LAS unsigned char* lds; volatile LAS unsigned* MISC; gu32* ctl;
    int tid, lane, wave, vcu, G;
};
__device__ __forceinline__ float wave_sum(float v) {
#pragma unroll
    for (int o = 1; o < 64; o <<= 1) v += __shfl_xor(v, o);
    return v;
}
__device__ __forceinline__ int mod_row(int r) { return r < MP ? (r >> 11) : BP + ((r - MP) >> 3); }

__device__ __forceinline__ void p0_transpose_item(const float* W, int K, int N, bf16* WT, int row_off, LAS float* scr, int item, int lane) {
    const int nblk = N / 32, kb = item / nblk, nb = item % nblk, k0 = 64 * kb, n0 = 32 * nb;
#pragma unroll 8
    for (int i = 0; i < 32; ++i) { const int kk = 2 * i + (lane >> 5); scr[kk * 33 + (lane & 31)] = W[(size_t)(k0 + kk) * N + n0 + (lane & 31)]; }
    LDS_WAIT(); asm volatile("" ::: "memory");
    const int c = lane & 7;
#pragma unroll
    for (int j = 0; j < 4; ++j) { const int n = (lane >> 3) + 8 * j; const LAS float* s = scr + (8 * c) * 33 + n;
        v4u o; o.x = pk2(s[0 * 33], s[1 * 33]); o.y = pk2(s[2 * 33], s[3 * 33]); o.z = pk2(s[4 * 33], s[5 * 33]); o.w = pk2(s[6 * 33], s[7 * 33]);
        *(GAS v4u*)(WT + (size_t)(row_off + n0 + n) * K + k0 + 8 * c) = o; }
    LDS_WAIT(); asm volatile("" ::: "memory");
}

__device__ __forceinline__ void p0_prologue(Frame& F, const Args& a) {
    LAS float* scr = (LAS float*)(F.lds + RING_OFF + F.wave * 16384);
    const int gw = F.vcu * NWAVES + F.wave, NGW = F.G * NWAVES;
    unsigned char* ws = a.ws;
    constexpr int I_IN = (D / 64) * (NIN / 32), I_OUT = (D / 64) * (D / 32), I_UP = (D / 64) * (FF / 32), I_DN = (FF / 64) * (D / 32), I_ADA = (D / 64) * (NMOD / 32);
    constexpr int PER_L = I_IN + I_OUT + I_UP + I_DN + I_ADA, NITEMS = NL * PER_L;
    for (int it = gw; it < NITEMS; it += NGW) {
        const int l = it / PER_L; int r = it % PER_L;
        if (r < I_ADA) { p0_transpose_item(a.in[6] + (size_t)l * D * NMOD, D, NMOD, (bf16*)(ws + WS_WADA), l * NMOD, scr, r, F.lane); continue; } r -= I_ADA;
        if (r < I_IN) { p0_transpose_item(a.in[8] + (size_t)l * D * NIN, D, NIN, (bf16*)(ws + WS_WIN) + (size_t)l * NIN * D, 0, scr, r, F.lane); continue; } r -= I_IN;
        if (r < I_OUT) { p0_transpose_item(a.in[16] + (size_t)l * D * D, D, D, (bf16*)(ws + WS_WOUT) + (size_t)l * D * D, 0, scr, r, F.lane); continue; } r -= I_OUT;
        if (r < I_UP) { p0_transpose_item(a.in[19] + (size_t)l * D * FF, D, FF, (bf16*)(ws + WS_WUP) + (size_t)l * FF * D, 0, scr, r, F.lane); continue; } r -= I_UP;
        p0_transpose_item(a.in[20] + (size_t)l * FF * D, FF, D, (bf16*)(ws + WS_WDN) + (size_t)l * D * FF, 0, scr, r, F.lane);
    }
    bf16* AC = (bf16*)(ws + WS_AC);
    for (int m = gw; m < NMODROW; m += NGW) {
        GAS unsigned long long* o8 = (GAS unsigned long long*)(AC + (size_t)m * D) + F.lane;
        if (m < BP + BS) { const float* crow = m < BP ? a.in[2] + (size_t)m * D : a.in[3] + (size_t)(m - BP) * D;
            const GAS f32x4* xr = (const GAS f32x4*)crow + F.lane;
#pragma unroll
            for (int j = 0; j < 4; ++j) { f32x4 v = xr[64 * j];
#pragma unroll
                for (int e = 0; e < 4; ++e) v[e] = v[e] / (1.0f + __expf(-v[e]));
                o8[64 * j] = (unsigned long long)pk2(v.x, v.y) | ((unsigned long long)pk2(v.z, v.w) << 32); }
        } else {
#pragma unroll
            for (int j = 0; j < 4; ++j) o8[64 * j] = 0ull; }
    }
}

__device__ __forceinline__ void modulate_rows(Frame& F, const float* xp, const float* xs, const float* mod_sh, const float* mod_sc, bf16* hb) {
    const int gw = F.vcu * NWAVES + F.wave, NGW = F.G * NWAVES;
    for (int r = gw; r < M; r += NGW) {
        const float* xrow = r < MP ? xp + (size_t)r * D : xs + (size_t)(r - MP) * D; const int mr = mod_row(r);
        const GAS f32x4* xr = (const GAS f32x4*)xrow + F.lane; const GAS f32x4* sh = (const GAS f32x4*)(mod_sh + (size_t)mr * MODLD) + F.lane; const GAS f32x4* sc = (const GAS f32x4*)(mod_sc + (size_t)mr * MODLD) + F.lane;
        GAS unsigned long long* o8 = (GAS unsigned long long*)(hb + (size_t)r * D) + F.lane;
#pragma unroll
        for (int j = 0; j < 4; ++j) { const f32x4 v = xr[64 * j], a = sh[64 * j], b = sc[64 * j]; const f32x4 h = v * (b + 1.0f) + a;
            o8[64 * j] = (unsigned long long)pk2(h.x, h.y) | ((unsigned long long)pk2(h.z, h.w) << 32); }
    }
}
__device__ __forceinline__ void ln_rows(Frame& F, float* x, const float* g, const float* b, const float* mod_sh, const float* mod_sc, bf16* hb) {
    const int gw = F.vcu * NWAVES + F.wave, NGW = F.G * NWAVES;
    for (int r = gw; r < M; r += NGW) {
        GAS f32x4* xr = (GAS f32x4*)(x + (size_t)r * D) + F.lane; const int mr = mod_row(r);
        f32x4 v[4]; float s = 0.f;
#pragma unroll
        for (int j = 0; j < 4; ++j) { v[j] = xr[64 * j]; s += (v[j].x + v[j].y) + (v[j].z + v[j].w); }
        const float mean = wave_sum(s) * (1.f / D); float s2 = 0.f;
#pragma unroll
        for (int j = 0; j < 4; ++j) { v[j] = v[j] - mean; s2 += (v[j].x * v[j].x + v[j].y * v[j].y) + (v[j].z * v[j].z + v[j].w * v[j].w); }
        const float rstd = 1.f / sqrtf(wave_sum(s2) * (1.f / D) + LN_EPS);
#pragma unroll
        for (int j = 0; j < 4; ++j) { const f32x4 gg = ((const GAS f32x4*)g)[F.lane + 64 * j], bb = ((const GAS f32x4*)b)[F.lane + 64 * j]; v[j] = v[j] * rstd * gg + bb; xr[64 * j] = v[j]; }
        if (hb) { const GAS f32x4* sh = (const GAS f32x4*)(mod_sh + (size_t)mr * MODLD) + F.lane; const GAS f32x4* sc = (const GAS f32x4*)(mod_sc + (size_t)mr * MODLD) + F.lane;
            GAS unsigned long long* o8 = (GAS unsigned long long*)(hb + (size_t)r * D) + F.lane;
#pragma unroll
            for (int j = 0; j < 4; ++j) { const f32x4 h = v[j] * (sc[64 * j] + 1.0f) + sh[64 * j]; o8[64 * j] = (unsigned long long)pk2(h.x, h.y) | ((unsigned long long)pk2(h.z, h.w) << 32); } }
    }
}

__device__ __forceinline__ void unpack4(v2u w, float (&f)[4]) { f[0] = bflo(w.x); f[1] = bfhi(w.x); f[2] = bflo(w.y); f[3] = bfhi(w.y); }

__device__ __forceinline__ void conv_phase(Frame& F, const Args& a, int l, const bf16* proj, bf16* mix) {
    const int gt = F.vcu * (NWAVES * 64) + F.tid, NGT = F.G * NWAVES * 64;
    const float* cw = a.in[9] + (size_t)l * 3 * 256;
    for (int it = gt; it < (M / 8) * 64; it += NGT) {
        const int cg = it & 63, tg = it >> 6, r0 = tg * 8, c = cg * 4; const bool samp = r0 >= MP;
        const int t0 = samp ? 0 : (r0 & (TP - 1)); const int sb = samp ? (r0 - MP) >> 3 : (r0 >> 11);
        float zm2[4] = {0.f, 0.f, 0.f, 0.f}, zm1[4] = {0.f, 0.f, 0.f, 0.f};
        if (samp) { const float* st = a.in[4] + ((size_t)(l * BS + sb) * 2) * 256 + c; const f32x4 s0 = *(const f32x4*)st, s1 = *(const f32x4*)(st + 256);
#pragma unroll
            for (int e = 0; e < 4; ++e) { zm2[e] = s0[e]; zm1[e] = s1[e]; } }
        else if (t0 != 0) { float p[4], q[4];
            unpack4(*(const v2u*)(proj + (size_t)(r0 - 2) * NIN + 256 + c), p); unpack4(*(const v2u*)(proj + (size_t)(r0 - 2) * NIN + 512 + c), q);
#pragma unroll
            for (int e = 0; e < 4; ++e) zm2[e] = p[e] * q[e];
            unpack4(*(const v2u*)(proj + (size_t)(r0 - 1) * NIN + 256 + c), p); unpack4(*(const v2u*)(proj + (size_t)(r0 - 1) * NIN + 512 + c), q);
#pragma unroll
            for (int e = 0; e < 4; ++e) zm1[e] = p[e] * q[e]; }
        const f32x4 w0 = *(const f32x4*)(cw + c), w1 = *(const f32x4*)(cw + 256 + c), w2 = *(const f32x4*)(cw + 512 + c);
        const bool last_p = (!samp) && (t0 + 8 == TP);
#pragma unroll
        for (int tt = 0; tt < 8; ++tt) { const size_t ro = (size_t)(r0 + tt) * NIN; float ab[4], ac[4], ax[4], z[4], y[4];
            unpack4(*(const v2u*)(proj + ro + c), ab); unpack4(*(const v2u*)(proj + ro + 256 + c), ac); unpack4(*(const v2u*)(proj + ro + 512 + c), ax);
#pragma unroll
            for (int e = 0; e < 4; ++e) { z[e] = ac[e] * ax[e]; y[e] = ab[e] * (zm2[e] * w0[e] + zm1[e] * w1[e] + z[e] * w2[e]); zm2[e] = zm1[e]; zm1[e] = z[e]; }
            v2u o; o.x = pk2(y[0], y[1]); o.y = pk2(y[2], y[3]); *(v2u*)(mix + (size_t)(r0 + tt) * D + c) = o;
            if (tt >= 6) { const f32x4 zz = {z[0], z[1], z[2], z[3]};
                if (samp) *(f32x4*)(a.out + O_CS + ((size_t)(l * BS + sb) * 2 + (tt - 6)) * 256 + c) = zz;
                else if (last_p) *(f32x4*)(a.out + O_CP + ((size_t)(l * BP + sb) * 2 + (tt - 6)) * 256 + c) = zz; }
        }
    }
}

template <int W> __device__ __forceinline__ void pool_item(Frame& F, const Args& a, int l, const bf16* proj, bf16* mix, int tg, int g) {
    const int lane = F.lane, ch = g * 64 + lane, r0 = tg * 8; const bool samp = r0 >= MP;
    const int t0 = samp ? 0 : (r0 & (TP - 1)); const int sb = samp ? (r0 - MP) >> 3 : (r0 >> 11);
    float e[W - 1 + 8];
#pragma unroll
    for (int k = -(W - 1); k < 8; ++k) { float v;
        if (k >= 0) v = bf1(proj[(size_t)(r0 + k) * NIN + 1792 + ch]);
        else if (samp) v = a.in[5][((size_t)(l * BS + sb) * 15 + (15 + k)) * 256 + ch];
        else v = (t0 + k >= 0) ? bf1(proj[(size_t)(r0 + k) * NIN + 1792 + ch]) : 0.f;
        e[k + W - 1] = v; }
    float d[8];
#pragma unroll
    for (int tt = 0; tt < 8; ++tt) { float s = 0.f;
#pragma unroll
        for (int i = 0; i < W; ++i) s += e[tt - i + W - 1];
        const int cnt = samp ? W : ((t0 + tt + 1) < W ? (t0 + tt + 1) : W);
        d[tt] = s / (float)cnt - e[tt + W - 1]; }
    float acc[8] = {0.f, 0.f, 0.f, 0.f, 0.f, 0.f, 0.f, 0.f};
    const float* pw = a.in[14] + ((size_t)(l * 4 + g) * 64) * 64 + lane;
    for (int c = 0; c < 64; ++c) { const float w = pw[(size_t)c * 64];
#pragma unroll
        for (int tt = 0; tt < 8; ++tt) acc[tt] += __builtin_bit_cast(float, __builtin_amdgcn_readlane(__builtin_bit_cast(int, d[tt]), c)) * w; }
    const float ps = a.in[15][l * 256 + ch];
#pragma unroll
    for (int tt = 0; tt < 8; ++tt) mix[(size_t)(r0 + tt) * D + 768 + ch] = (bf16)f2bf(acc[tt] * ps);
    if (samp) { float* o = a.out + O_PS + ((size_t)(l * BS + sb) * 15) * 256 + ch;
#pragma unroll
        for (int j = 0; j < 7; ++j) o[(size_t)j * 256] = a.in[5][((size_t)(l * BS + sb) * 15 + (8 + j)) * 256 + ch];
#pragma unroll
        for (int j = 7; j < 15; ++j) o[(size_t)j * 256] = e[(j - 7) + W - 1];
    } else if (t0 + 8 > TP - 15) { float* o = a.out + O_PP + ((size_t)(l * BP + sb) * 15) * 256 + ch;
#pragma unroll
        for (int tt = 0; tt < 8; ++tt) { const int j = t0 + tt - (TP - 15); if (j >= 0) o[(size_t)j * 256] = e[tt + W - 1]; } }
}
__device__ __forceinline__ void pool_phase(Frame& F, const Args& a, int l, const bf16* proj, bf16* mix) {
    const int gw = F.vcu * NWAVES + F.wave, NGW = F.G * NWAVES;
    for (int it = gw; it < (M / 8) * 4; it += NGW) { const int g = it & 3, tg = it >> 2;
        if (g == 0) pool_item<2>(F, a, l, proj, mix, tg, 0); else if (g == 1) pool_item<4>(F, a, l, proj, mix, tg, 1);
        else if (g == 2) pool_item<8>(F, a, l, proj, mix, tg, 2); else pool_item<16>(F, a, l, proj, mix, tg, 3); }
}

__device__ __forceinline__ void sgu_phase(Frame& F, const Args& a, int l, const bf16* proj, bf16* mix) {
    LAS float* VN = (LAS float*)(F.lds + RING_OFF);
    const float* sg = a.in[10] + l * 512; const float* sbv = a.in[11] + l * 512;
    for (int unit = F.vcu; unit < (M / 128) * 2; unit += F.G) {
        const int hh = unit & 1, ck = unit >> 1, r0 = ck * 128; const bool samp = r0 >= MP;
        for (int i = F.wave * 16; i < F.wave * 16 + 16; ++i) { const int r = r0 + i;
            const v4u raw = *(const v4u*)(proj + (size_t)r * NIN + 1280 + 8 * F.lane);
            float v[8] = {bflo(raw.x), bfhi(raw.x), bflo(raw.y), bfhi(raw.y), bflo(raw.z), bfhi(raw.z), bflo(raw.w), bfhi(raw.w)}; float s = 0.f;
#pragma unroll
            for (int k = 0; k < 8; ++k) s += v[k];
            const float mean = wave_sum(s) * (1.f / 512.f); float s2 = 0.f;
#pragma unroll
            for (int k = 0; k < 8; ++k) { v[k] -= mean; s2 += v[k] * v[k]; }
            const float rstd = 1.f / sqrtf(wave_sum(s2) * (1.f / 512.f) + LN_EPS);
            if ((F.lane >> 5) == hh) { const f32x4 g0 = *(const f32x4*)(sg + 8 * F.lane), g1 = *(const f32x4*)(sg + 8 * F.lane + 4), b0 = *(const f32x4*)(sbv + 8 * F.lane), b1 = *(const f32x4*)(sbv + 8 * F.lane + 4);
                f32x4 o0 = {v[0], v[1], v[2], v[3]}, o1 = {v[4], v[5], v[6], v[7]}; o0 = o0 * rstd * g0 + b0; o1 = o1 * rstd * g1 + b1;
                LAS f32x4* dst = (LAS f32x4*)(VN + i * 256 + 8 * (F.lane & 31)); dst[0] = o0; dst[1] = o1;
                if (samp) { float* vo = a.out + O_VS + ((size_t)l * MS + (r - MP)) * 512 + 8 * F.lane; *(f32x4*)vo = o0; *(f32x4*)(vo + 4) = o1; } }
        }
        LDS_WAIT(); __syncthreads();
        for (int p = F.wave; p < 4 * 128; p += NWAVES) { const int hl = p & 3, i = p >> 2, h = hh * 4 + hl, j0 = samp ? (i & ~7) : 0;
            const float* wrow = a.in[12] + ((size_t)(l * 8 + h) * 128 + (i - j0)) * 128; float acc = 0.f;
            for (int j = j0; j <= i; ++j) acc += wrow[j - j0] * VN[j * 256 + hl * 64 + F.lane];
            const float s = acc + a.in[13][(l * 8 + h) * 128 + (i - j0)];
            const float u = bf1(proj[(size_t)(r0 + i) * NIN + 768 + h * 64 + F.lane]);
            mix[(size_t)(r0 + i) * D + 256 + h * 64 + F.lane] = (bf16)f2bf(u * s); }
        LDS_WAIT(); __syncthreads();
    }
}

constexpr int N_PHASES = 3 + 7 * NL;
__global__ void __launch_bounds__(NWAVES * 64, 2) skel_fwd(Args args) {
    extern __shared__ __attribute__((aligned(16))) unsigned char lds[];
    Frame F;
    F.lds = (LAS unsigned char*)lds; F.MISC = (volatile LAS unsigned*)(F.lds + MISC_OFF);
    F.tid = threadIdx.x; F.lane = F.tid & 63; F.wave = __builtin_amdgcn_readfirstlane(F.tid >> 6);
    F.G = gridDim.x; { const int bx = blockIdx.x; F.vcu = (F.G % 8 == 0) ? (bx % 8) * (F.G / 8) + bx / 8 : bx; }
    unsigned char* ws = args.ws; F.ctl = (gu32*)(ws + WS_CTL);
    for (int u = F.tid; u < (LDS_BYTES - LDSCTL_OFF) / 4; u += NWAVES * 64) ((LAS unsigned*)(F.lds + LDSCTL_OFF))[u] = 0u;
    __syncthreads();
    const int lo = args.ph_lo, hi = args.ph_hi;
    XcdBarrier bar; bar.bar = (unsigned*)(F.ctl + CW_BAR); bar.x = 0; bar.st = nullptr;
    if (hi - lo > 1) bar = xcd_barrier_post((unsigned*)(F.ctl + CW_BAR), F.MISC + 8);
#define IN(k) (lo <= (k) && (k) < hi)
#define FRESH() do { int t_ = threadIdx.x; asm volatile("" : "+v"(t_)); F.tid = t_; F.lane = t_ & 63; } while (0)
#define SEAM(k) do { if (IN(k) && IN((k) + 1)) xcd_barrier(bar); } while (0)
    bf16* const WIN = (bf16*)(ws + WS_WIN); bf16* const WOUT = (bf16*)(ws + WS_WOUT); bf16* const WUP = (bf16*)(ws + WS_WUP); bf16* const WDN = (bf16*)(ws + WS_WDN);
    float* const MOD = (float*)(ws + WS_MOD); bf16* const HA = (bf16*)(ws + WS_HA); bf16* const PROJ = (bf16*)(ws + WS_PROJ); bf16* const MIX = (bf16*)(ws + WS_MIX); bf16* const HID = (bf16*)(ws + WS_HID);
    float* const Y = args.out;

#ifndef DIS_PRO
    if (IN(0)) { FRESH(); p0_prologue(F, args); SEAM(0); }
#endif
    if (IN(1)) {
        pg8::Gemm g{(const bf16*)(ws + WS_AC), (const bf16*)(ws + WS_WADA), NMODROW, MODLD, D}; pg8::StaticOrder S; S.init(NMODROW, MODLD, F.G, (int)blockIdx.x);
        pg8::EpiF32 E{MOD, MODLD, args.in[7]};
        pg8::gemm_phase<pg8::EpiF32, pg8::StaticOrder, true, true>(F.lds + RING_OFF, g, S, E); SEAM(1); }
    if (IN(2)) { FRESH(); modulate_rows(F, args.in[0], args.in[1], MOD + 0, MOD + 1024, HA); SEAM(2); }
#pragma unroll 1
    for (int l = 0; l < NL; ++l) {
        const int pb = 3 + 7 * l; const float* modl = MOD + (size_t)l * NMOD;
        if (IN(pb + 0)) { pg8::Gemm g{HA, WIN + (size_t)l * NIN * D, M, NIN, D}; pg8::StaticOrder S; S.init(M, NIN, F.G, (int)blockIdx.x);
            pg8::EpiBf16<0> E{PROJ, NIN, nullptr, 0, 0, 1.f};
            pg8::gemm_phase<pg8::EpiBf16<0>, pg8::StaticOrder, true, true>(F.lds + RING_OFF, g, S, E); SEAM(pb + 0); }
        if (IN(pb + 1)) {
#ifndef DIS_CONV
 FRESH(); conv_phase(F, args, l, PROJ, MIX);
#endif
#ifndef DIS_POOL
 FRESH(); pool_phase(F, args, l, PROJ, MIX);
#endif
#ifndef DIS_SGU
 FRESH(); sgu_phase(F, args, l, PROJ, MIX);
#endif
 SEAM(pb + 1); }
        if (IN(pb + 2)) { pg8::Gemm g{MIX, WOUT + (size_t)l * D * D, M, D, D}; pg8::StaticOrder S; S.init(M, D, F.G, (int)blockIdx.x);
            pg8::EpiRes E{l == 0 ? args.in[0] : Y, l == 0 ? args.in[1] : Y + (size_t)MP * D, Y, modl + 2048, DN_ALPHA};
            pg8::gemm_phase<pg8::EpiRes, pg8::StaticOrder, true, true>(F.lds + RING_OFF, g, S, E); SEAM(pb + 2); }
        if (IN(pb + 3)) { FRESH(); ln_rows(F, Y, args.in[17] + l * D, args.in[18] + l * D, modl + 3072, modl + 4096, HA); SEAM(pb + 3); }
        if (IN(pb + 4)) { pg8::Gemm g{HA, WUP + (size_t)l * FF * D, M, FF, D}; pg8::StaticOrder S; S.init(M, FF, F.G, (int)blockIdx.x);
            pg8::EpiBf16<2> E{HID, FF, nullptr, 0, 0, 1.f};
            pg8::gemm_phase<pg8::EpiBf16<2>, pg8::StaticOrder, true, true>(F.lds + RING_OFF, g, S, E); SEAM(pb + 4); }
        if (IN(pb + 5)) { pg8::Gemm g{HID, WDN + (size_t)l * D * FF, M, D, FF}; pg8::StaticOrder S; S.init(M, D, F.G, (int)blockIdx.x);
            pg8::EpiRes E{Y, Y + (size_t)MP * D, Y, modl + 5120, DN_ALPHA};
            pg8::gemm_phase<pg8::EpiRes, pg8::StaticOrder, true, true>(F.lds + RING_OFF, g, S, E); SEAM(pb + 5); }
        if (IN(pb + 6)) { FRESH(); const bool more = (l + 1 < NL);
            ln_rows(F, Y, args.in[21] + l * D, args.in[22] + l * D, modl + NMOD + 0, modl + NMOD + 1024, more ? HA : nullptr); SEAM(pb + 6); }
    }
#undef IN
#undef SEAM
}

#ifndef MK_ONE_LAUNCH
#define MK_ONE_LAUNCH 0
#endif
extern "C" void kernel_launch(void* const* d_in, const int* in_sizes, int n_in, void* d_out, int out_size, void* d_ws, size_t ws_size, hipStream_t stream) {
    static int grid = 0;
    if (grid == 0) {
        if (n_in != 23 || (size_t)out_size != O_END || ws_size < WS_END) { fprintf(stderr, "kernel_launch: unexpected shapes: n_in %d out %d ws %zu\n", n_in, out_size, ws_size); grid = -1; return; }
        int dev = 0, cus = 0, per_cu = 0;
        if (hipGetDevice(&dev) != hipSuccess || hipDeviceGetAttribute(&cus, hipDeviceAttributeMultiprocessorCount, dev) != hipSuccess) { grid = -1; return; }
        if (hipFuncSetAttribute((const void*)skel_fwd, hipFuncAttributeMaxDynamicSharedMemorySize, LDS_BYTES) != hipSuccess) { fprintf(stderr, "kernel_launch: hipFuncSetAttribute failed\n"); grid = -1; return; }
        if (hipOccupancyMaxActiveBlocksPerMultiprocessor(&per_cu, (const void*)skel_fwd, NWAVES * 64, LDS_BYTES) != hipSuccess || per_cu < 1) { fprintf(stderr, "kernel_launch: occupancy query says %d\n", per_cu); per_cu = 1; }
        (void)hipGetLastError();
        grid = cus * (per_cu < 1 ? 1 : 1);
    }
    if (grid < 0) return;
    if (hipMemsetAsync((char*)d_ws + WS_CTL, 0, CTL_ZERO_BYTES, stream) != hipSuccess) return;
    Args a{};
    for (int i = 0; i < 23; ++i) a.in[i] = (const float*)d_in[i];
    a.out = (float*)d_out; a.ws = (unsigned char*)d_ws;
#if MK_ONE_LAUNCH
    a.ph_lo = 0; a.ph_hi = N_PHASES;
    hipLaunchKernelGGL(skel_fwd, dim3(grid), dim3(NWAVES * 64), LDS_BYTES, stream, a);
#else
    for (int p = 0; p < N_PHASES; ++p) { a.ph_lo = p; a.ph_hi = p + 1; hipLaunchKernelGGL(skel_fwd, dim3(grid), dim3(NWAVES * 64), LDS_BYTES, stream, a); }
#endif
}
```

```cpp
#include <hip/hip_runtime.h>
#include <cstdio>
#include <cstdint>
namespace pg8 {
#define PG8_LAS __attribute__((address_space(3)))
typedef unsigned short bf16_t;
typedef short bf16x8 __attribute__((ext_vector_type(8)));
typedef float f32x4 __attribute__((ext_vector_type(4)));
typedef unsigned u32x4 __attribute__((ext_vector_type(4)));
constexpr int BM = 256, BK = 64, HALF = 128, HTB = HALF * BK * 2  , STAGE_BYTES = 8 * HTB, NXCD = 8, WGM = 8;

__host__ __device__ __forceinline__ int lds_byte(int r, int c) { const int st = (r >> 4) * 2 + (c >> 5), rr = r & 15, cc = c & 31, ob = rr * 64 + cc * 2; return st * 1024 + (ob ^ (((ob >> 9) & 1) << 5)); }
__host__ __device__ __forceinline__ void stage_rc(int b, int& R, int& C) { const int st = b / 1024, sb = b % 1024, swz = sb ^ (((sb >> 9) & 1) << 5); R = (st >> 1) * 16 + swz / 64; C = (st & 1) * 32 + (swz % 64) / 2; }
__host__ __device__ __forceinline__ int perm32(int rho) { const int n = rho >> 4, i = rho & 15; return 8 * (i >> 2) + 4 * n + (i & 3); }

struct Unit { int pm, pn; };
struct Gemm { const bf16_t* A; const bf16_t* Bt; int M, N, K; };

struct StaticOrder {
    int nM, nN, nwg, G, c;
    __host__ __device__ void init(int M, int N, int G_, int c_) { nM = M / BM; nN = N / BM; nwg = nM * nN; G = G_; c = c_; }
    __host__ __device__ bool next(int i, Unit& u) const {
        const long L = (long)i * G + c; if (L >= nwg) return false;
        int wgid = (int)L; { const int q = nwg / NXCD, r = nwg % NXCD, xcd = wgid % NXCD, off = wgid / NXCD; wgid = (xcd < r ? xcd * (q + 1) : r * (q + 1) + (xcd - r) * q) + off; }
        const int nig = WGM * nN, gid = wgid / nig, fm = gid * WGM, gsz = (nM - fm) < WGM ? (nM - fm) : WGM;
        u.pm = fm + ((wgid % nig) % gsz); u.pn = (wgid % nig) / gsz; return true;
    }
    __device__ __forceinline__ void a_ready(const Unit&) const {}
    __device__ __forceinline__ void done(const Unit&) const {}
};

__device__ __forceinline__ unsigned cvt_pk_bf16(float lo, float hi) { unsigned r; asm volatile("v_cvt_pk_bf16_f32 %0, %1, %2" : "=v"(r) : "v"(lo), "v"(hi)); return r; }
typedef float f32x2 __attribute__((ext_vector_type(2)));
__device__ __forceinline__ f32x2 gelu_pk(f32x2 v) {
    const f32x2 av = __builtin_elementwise_abs(v), d = av * 0.2316418882f + 1.0f;
    f32x2 t; t.x = __builtin_amdgcn_rcpf(d.x); t.y = __builtin_amdgcn_rcpf(d.y);
    f32x2 q = t * 0.5307027145f + (-0.7265760135f); q = q * t + 0.7107068705f; q = q * t + (-0.142248368f); q = q * t + 0.127414796f; q = q * t;
    const f32x2 s = (v * v) * (-0.72134752044f);
    f32x2 e; e.x = __builtin_amdgcn_exp2f(s.x); e.y = __builtin_amdgcn_exp2f(s.y);
    const f32x2 m = v * (q * e), r = v - m;
    f32x2 o; o.x = v.x < 0.f ? m.x : r.x; o.y = v.y < 0.f ? m.y : r.y; return o;
}

struct EpiF32 {
    static constexpr bool PERM = false, AFTER_DRAIN = false;
    float* C; int ldc; const float* bias;
    __device__ __forceinline__ void operator()(const f32x4 (&acc)[2][2][4][2], const Unit& u, int wr, int wc, int fr, int fq) const {
        const int row0 = u.pm * BM + wr * 64 + fr, col0 = u.pn * BM + wc * 32 + 4 * fq;
        f32x4 bv[2][2];
#pragma unroll
        for (int bj = 0; bj < 2; ++bj)
#pragma unroll
            for (int n = 0; n < 2; ++n) bv[bj][n] = bias ? *(const f32x4*)(bias + col0 + bj * HALF + n * 16) : (f32x4){0.f, 0.f, 0.f, 0.f};
#pragma unroll
        for (int ai = 0; ai < 2; ++ai)
#pragma unroll
            for (int m = 0; m < 4; ++m) { float* rowp = C + (size_t)(row0 + ai * HALF + m * 16) * ldc + col0;
#pragma unroll
                for (int bj = 0; bj < 2; ++bj)
#pragma unroll
                    for (int n = 0; n < 2; ++n) *(f32x4*)(rowp + bj * HALF + n * 16) = acc[ai][bj][m][n] + bv[bj][n]; }
    }
};
template <int ACT  > struct EpiBf16 {
    static constexpr bool PERM = true, AFTER_DRAIN = false; static_assert(ACT == 0 || ACT == 1 || ACT == 2, "EpiBf16: ACT is 0 (none), 1 (gelu_pk) or 2 (squared relu)");
    bf16_t* O; int ldc; const float* bias; int split_cols; size_t split_stride; float scale0;
    __device__ __forceinline__ void operator()(const f32x4 (&acc)[2][2][4][2], const Unit& u, int wr, int wc, int fr, int fq) const {
        const int row0 = u.pm * BM + wr * 64 + fr; int colt = u.pn * BM; bf16_t* base = O;
        float sc = 1.f; if (split_cols) { const int t = colt / split_cols; base += (size_t)t * split_stride; colt -= t * split_cols; if (t == 0) sc = scale0; }
        const int col0 = colt + wc * 32 + 8 * fq, bcol0 = u.pn * BM + wc * 32 + 8 * fq;
        f32x4 bv[2][2];
#pragma unroll
        for (int bj = 0; bj < 2; ++bj)
#pragma unroll
            for (int n = 0; n < 2; ++n) bv[bj][n] = bias ? *(const f32x4*)(bias + bcol0 + bj * HALF + 4 * n) : (f32x4){0.f, 0.f, 0.f, 0.f};
#pragma unroll
        for (int ai = 0; ai < 2; ++ai)
#pragma unroll
            for (int m = 0; m < 4; ++m) { bf16_t* rowp = base + (size_t)(row0 + ai * HALF + m * 16) * ldc + col0;
#pragma unroll
                for (int bj = 0; bj < 2; ++bj) { f32x4 v0 = acc[ai][bj][m][0] + bv[bj][0], v1 = acc[ai][bj][m][1] + bv[bj][1];
                    if (ACT == 1) { f32x2 a = gelu_pk((f32x2){v0[0], v0[1]}), b = gelu_pk((f32x2){v0[2], v0[3]}), c = gelu_pk((f32x2){v1[0], v1[1]}), d = gelu_pk((f32x2){v1[2], v1[3]});
                        v0 = (f32x4){a.x, a.y, b.x, b.y}; v1 = (f32x4){c.x, c.y, d.x, d.y}; }
                    if (ACT == 2) { v0 = __builtin_elementwise_max(v0, (f32x4){0.f, 0.f, 0.f, 0.f}); v1 = __builtin_elementwise_max(v1, (f32x4){0.f, 0.f, 0.f, 0.f}); v0 = v0 * v0; v1 = v1 * v1; }
                    v0 = v0 * sc; v1 = v1 * sc; u32x4 w; w.x = cvt_pk_bf16(v0[0], v0[1]); w.y = cvt_pk_bf16(v0[2], v0[3]); w.z = cvt_pk_bf16(v1[0], v1[1]); w.w = cvt_pk_bf16(v1[2], v1[3]);
                    *(u32x4*)(rowp + bj * HALF) = w; } }
    }
};

struct PanelStats {
    unsigned* xbuf;
    unsigned* cnt;
    unsigned* tmo;
    int ntn; float eps;
    unsigned code;
    __device__ __forceinline__ bool run(const f32x4 (&v)[2][2][4][2], const Unit& u, int wr, int wc, int fr, int fq, PG8_LAS unsigned char* lds, int wid, int lane) const {
        typedef float f32x2v __attribute__((ext_vector_type(2)));
        PG8_LAS f32x2v* P = (PG8_LAS f32x2v*)lds;
        PG8_LAS f32x2v* S = (PG8_LAS f32x2v*)(lds + 8192);
        PG8_LAS unsigned* flag = (PG8_LAS unsigned*)(lds + 8192 + 2048);
#pragma unroll
        for (int ai = 0; ai < 2; ++ai)
#pragma unroll
            for (int m = 0; m < 4; ++m) {
                float s = 0.f;
#pragma unroll
                for (int bj = 0; bj < 2; ++bj)
#pragma unroll
                    for (int n = 0; n < 2; ++n) { const f32x4 x = v[ai][bj][m][n]; s += (x[0] + x[1]) + (x[2] + x[3]); }
                s += __shfl_xor(s, 16); s += __shfl_xor(s, 32);
                const float mw = s * (1.0f / 64.0f); float q = 0.f;
#pragma unroll
                for (int bj = 0; bj < 2; ++bj)
#pragma unroll
                    for (int n = 0; n < 2; ++n) { const f32x4 d = v[ai][bj][m][n] - mw; q += (d[0] * d[0] + d[1] * d[1]) + (d[2] * d[2] + d[3] * d[3]); }
                q += __shfl_xor(q, 16); q += __shfl_xor(q, 32);
                if (fq == 0) P[(ai * HALF + wr * 64 + m * 16 + fr) * 4 + wc] = (f32x2v){mw, q};
            }
        asm volatile("s_waitcnt lgkmcnt(0)" ::: "memory"); __builtin_amdgcn_s_barrier(); asm volatile("" ::: "memory");
#if defined(BROKEN_EXCHANGE_NO_WAIT)
#warning BROKEN CONTROL BUILD: the row-statistics exchange does not wait; results are wrong by design
        if (blockIdx.x >= 64) { const long long t0_ = clock64(); while (clock64() - t0_ < 60000) __builtin_amdgcn_s_sleep(8); }
#endif
        const int row = wid * 32 + (lane & 31);
        if (lane < 32) {
            const f32x2v a = P[row * 4 + 0], b = P[row * 4 + 1], c = P[row * 4 + 2], d = P[row * 4 + 3];
            const float mt = (a.x + b.x + c.x + d.x) * 0.25f;
            const float da = a.x - mt, db = b.x - mt, dc = c.x - mt, dd = d.x - mt;
            const float m2 = (a.y + b.y) + (c.y + d.y) + 64.0f * ((da * da + db * db) + (dc * dc + dd * dd));
            unsigned long long* slot = (unsigned long long*)xbuf + ((size_t)(u.pm * BM + row) * 4 + u.pn);
            __hip_atomic_store(slot, ((unsigned long long)__float_as_uint(m2) << 32) | __float_as_uint(mt), __ATOMIC_RELAXED, __HIP_MEMORY_SCOPE_AGENT);
        }
        asm volatile("s_waitcnt vmcnt(0)" ::: "memory");
        if (lane == 0) __hip_atomic_fetch_add(cnt + 64 * u.pm, 1u, __ATOMIC_RELAXED, __HIP_MEMORY_SCOPE_AGENT);
        if (wid == 0) {
            bool dead = false; const unsigned long long t0 = __builtin_amdgcn_s_memrealtime(); const unsigned want = 8u * (unsigned)ntn;
            for (;;) {
#if defined(BROKEN_EXCHANGE_NO_WAIT)
                break;
#endif
                if ((unsigned)__builtin_amdgcn_readfirstlane(__hip_atomic_load(cnt + 64 * u.pm, __ATOMIC_RELAXED, __HIP_MEMORY_SCOPE_AGENT)) >= want) break;
                if (__builtin_amdgcn_s_memrealtime() - t0 > 2000000ull) {
                    if (lane == 0) { unsigned expect = 0u; __hip_atomic_compare_exchange_strong(tmo + 1, &expect, code | (unsigned)(u.pm & 0xff), __ATOMIC_RELAXED, __ATOMIC_RELAXED, __HIP_MEMORY_SCOPE_AGENT);
                                     __hip_atomic_store(tmo, 1u, __ATOMIC_RELAXED, __HIP_MEMORY_SCOPE_AGENT); }
                    dead = true; break; }
                __builtin_amdgcn_s_sleep(2);
            }
            __builtin_amdgcn_fence(__ATOMIC_ACQUIRE, "agent");
            if (lane == 0) flag[0] = dead ? 1u : 0u;
        }
        asm volatile("s_waitcnt vmcnt(0) lgkmcnt(0)" ::: "memory"); __builtin_amdgcn_s_barrier(); asm volatile("" ::: "memory");
        const bool bad = flag[0] != 0u;
        if (lane < 32) {
            const unsigned long long* slot = (const unsigned long long*)xbuf + (size_t)(u.pm * BM + row) * 4; float mt[4], m2[4]; float ms = 0.f;
#pragma unroll
            for (int t = 0; t < 4; ++t) { if (t < ntn) { const unsigned long long w = __hip_atomic_load(slot + t, __ATOMIC_RELAXED, __HIP_MEMORY_SCOPE_AGENT); mt[t] = __uint_as_float((unsigned)w); m2[t] = __uint_as_float((unsigned)(w >> 32)); } else { mt[t] = 0.f; m2[t] = 0.f; } ms += mt[t]; }
            const float mean = ms / (float)ntn; float q = 0.f;
#pragma unroll
            for (int t = 0; t < 4; ++t) if (t < ntn) { const float dm = mt[t] - mean; q += m2[t] + 256.0f * dm * dm; }
            S[row] = (f32x2v){mean, 1.0f / sqrtf(q / (256.0f * (float)ntn) + eps)};
        }
        asm volatile("s_waitcnt lgkmcnt(0)" ::: "memory"); __builtin_amdgcn_s_barrier(); asm volatile("" ::: "memory");
        return bad;
    }
};
struct EpiLnRes {
    static constexpr bool PERM = false, AFTER_DRAIN = true;
    const float* base; float* out; int ldc; const float* bias; PanelStats st; unsigned poison;
    __device__ __forceinline__ void fused(f32x4 (&acc)[2][2][4][2], const Unit& u, int wr, int wc, int fr, int fq, PG8_LAS unsigned char* lds, int wid, int lane) const {
        typedef float f32x2v __attribute__((ext_vector_type(2)));
        const PG8_LAS f32x2v* S = (const PG8_LAS f32x2v*)(lds + 8192);
        const int col0 = u.pn * BM + wc * 32 + 4 * fq;
#pragma unroll
        for (int bj = 0; bj < 2; ++bj)
#pragma unroll
            for (int n = 0; n < 2; ++n) { const f32x4 bv = bias ? *(const f32x4*)(bias + col0 + bj * HALF + n * 16) : (f32x4){0.f, 0.f, 0.f, 0.f};
#pragma unroll
                for (int ai = 0; ai < 2; ++ai)
#pragma unroll
                    for (int m = 0; m < 4; ++m) acc[ai][bj][m][n] += bv; }
        f32x4 pre[4][2][2];
#pragma unroll
        for (int m = 0; m < 4; ++m) { const size_t off = (size_t)(u.pm * BM + wr * 64 + m * 16 + fr) * ldc + col0;
#pragma unroll
            for (int bj = 0; bj < 2; ++bj)
#pragma unroll
                for (int n = 0; n < 2; ++n) pre[m][bj][n] = *(const f32x4*)(base + off + bj * HALF + n * 16); }
        const bool bad = st.run(acc, u, wr, wc, fr, fq, lds, wid, lane) || poison != 0u;
        const float qnan = __builtin_nanf("");
#pragma unroll
        for (int ai = 0; ai < 2; ++ai)
#pragma unroll
            for (int m = 0; m < 4; ++m) { const int r = ai * HALF + wr * 64 + m * 16 + fr; const f32x2v sr = S[r]; const size_t off = (size_t)(u.pm * BM + r) * ldc + col0;
#pragma unroll
                for (int bj = 0; bj < 2; ++bj)
#pragma unroll
                    for (int n = 0; n < 2; ++n) { const f32x4 bs = ai == 0 ? pre[m][bj][n] : *(const f32x4*)(base + off + bj * HALF + n * 16); f32x4 o = bs + (acc[ai][bj][m][n] - sr.x) * sr.y;
                        if (bad) o = (f32x4){qnan, qnan, qnan, qnan}; *(f32x4*)(out + off + bj * HALF + n * 16) = o; }
                if (m & 1) asm volatile("" ::: "memory"); }
    }
};
struct EpiLnResLn {
    static constexpr bool PERM = false, AFTER_DRAIN = true;
    const float* base; float* out; bf16_t* xn; int ldc; const float* bias; PanelStats st1, st2; unsigned poison;
    __device__ __forceinline__ void fused(f32x4 (&acc)[2][2][4][2], const Unit& u, int wr, int wc, int fr, int fq, PG8_LAS unsigned char* lds, int wid, int lane) const {
        typedef float f32x2v __attribute__((ext_vector_type(2))); typedef unsigned u32x2v __attribute__((ext_vector_type(2)));
        const PG8_LAS f32x2v* S = (const PG8_LAS f32x2v*)(lds + 8192);
        const int col0 = u.pn * BM + wc * 32 + 4 * fq;
#pragma unroll
        for (int bj = 0; bj < 2; ++bj)
#pragma unroll
            for (int n = 0; n < 2; ++n) { const f32x4 bv = bias ? *(const f32x4*)(bias + col0 + bj * HALF + n * 16) : (f32x4){0.f, 0.f, 0.f, 0.f};
#pragma unroll
                for (int ai = 0; ai < 2; ++ai)
#pragma unroll
                    for (int m = 0; m < 4; ++m) acc[ai][bj][m][n] += bv; }
        bool bad = st1.run(acc, u, wr, wc, fr, fq, lds, wid, lane) || poison != 0u;
        const float qnan = __builtin_nanf("");
#pragma unroll
        for (int ai = 0; ai < 2; ++ai)
#pragma unroll
            for (int m = 0; m < 4; ++m) { const int r = ai * HALF + wr * 64 + m * 16 + fr; const f32x2v sr = S[r]; const size_t off = (size_t)(u.pm * BM + r) * ldc + col0;
#pragma unroll
                for (int bj = 0; bj < 2; ++bj)
#pragma unroll
                    for (int n = 0; n < 2; ++n) { const f32x4 bs = *(const f32x4*)(base + off + bj * HALF + n * 16); acc[ai][bj][m][n] = bs + (acc[ai][bj][m][n] - sr.x) * sr.y; }
                asm volatile("" : "+v"(acc[ai][0][m][0]), "+v"(acc[ai][0][m][1]), "+v"(acc[ai][1][m][0]), "+v"(acc[ai][1][m][1]));
                if (m & 1) asm volatile("" ::: "memory"); }
        const bool bad1 = bad;
        bad = st2.run(acc, u, wr, wc, fr, fq, lds, wid, lane) || bad;
#pragma unroll
        for (int ai = 0; ai < 2; ++ai)
#pragma unroll
            for (int m = 0; m < 4; ++m) { const int r = ai * HALF + wr * 64 + m * 16 + fr; const f32x2v sr = S[r]; const size_t off = (size_t)(u.pm * BM + r) * ldc + col0;
#pragma unroll
                for (int bj = 0; bj < 2; ++bj)
#pragma unroll
                    for (int n = 0; n < 2; ++n) { const f32x4 x1 = acc[ai][bj][m][n]; *(f32x4*)(out + off + bj * HALF + n * 16) = bad1 ? (f32x4){qnan, qnan, qnan, qnan} : x1;
                        const f32x4 o = (x1 - sr.x) * sr.y; u32x2v w; w.x = cvt_pk_bf16(o[0], o[1]); w.y = cvt_pk_bf16(o[2], o[3]);
                        if (bad) { w.x = 0x7fc07fc0u; w.y = 0x7fc07fc0u; } *(u32x2v*)(xn + off + bj * HALF + n * 16) = w; }
                asm volatile("" ::: "memory"); }
    }
};


struct EpiRes {
    static constexpr bool PERM = false, AFTER_DRAIN = false;
    const float* xp; const float* xs; float* out; const float* gate; float alpha;
    __device__ __forceinline__ void operator()(const f32x4 (&acc)[2][2][4][2], const Unit& u, int wr, int wc, int fr, int fq) const {
        const int row0 = u.pm * BM + wr * 64 + fr, col0 = u.pn * BM + wc * 32 + 4 * fq; const bool samp = u.pm >= 64;
#pragma unroll
        for (int ai = 0; ai < 2; ++ai)
#pragma unroll
            for (int m = 0; m < 4; ++m) { const int r = row0 + ai * HALF + m * 16;
                const float* xrow = samp ? xs + (size_t)(r - 16384) * 1024 : xp + (size_t)r * 1024;
                const int mr = samp ? 8 + ((r - 16384) >> 3) : (r >> 11);
                const float* grow = gate + (size_t)mr * 12288; float* orow = out + (size_t)r * 1024;
#pragma unroll
                for (int bj = 0; bj < 2; ++bj)
#pragma unroll
                    for (int n = 0; n < 2; ++n) { const int c = col0 + bj * HALF + n * 16; const f32x4 xv = *(const f32x4*)(xrow + c), gv = *(const f32x4*)(grow + c);
                        *(f32x4*)(orow + c) = xv * alpha + gv * acc[ai][bj][m][n]; }
                asm volatile("" ::: "memory"); }
    }
};
template <class Epi, class Sched, bool ALIGN_EPI = false, bool SP2 = false>
__device__ __forceinline__ void gemm_phase(PG8_LAS unsigned char* lds, const Gemm g, const Sched& S, const Epi& E) {
    int tid_ = threadIdx.x; asm volatile("" : "+v"(tid_));
    const int tid = tid_, wid = __builtin_amdgcn_readfirstlane(tid >> 6), lane = tid & 63, wr = wid >> 2, wc = wid & 3, fr = lane & 15, fq = lane >> 4;
    const int K = g.K, nt = K / BK;
    unsigned voffA[2], voffB[2];
#pragma unroll
    for (int i = 0; i < 2; ++i) { int R, C; stage_rc(tid * 16 + i * 8192, R, C); const int Rb = Epi::PERM ? ((R & ~31) + perm32(R & 31)) : R;
        voffA[i] = (unsigned)(R * K + C) * 2u; voffB[i] = (unsigned)(Rb * K + C) * 2u; }
    const size_t kstep = (size_t)(BK * 2);
    const size_t hstep = (size_t)HALF * K * 2;
    const size_t tstep = 2 * hstep;
    const unsigned ldsw = (unsigned)wid * 1024u;
    const int aoff = lds_byte(wr * 64 + fr, fq * 8), boff = lds_byte(wc * 32 + fr, fq * 8);
#define PG8_SA(b, h) (((b) * 2 + (h)) * HTB)
#define PG8_SB(b, h) ((4 + (b) * 2 + (h)) * HTB)
#define PG8_STAGE(bufoff, gbase, voff) do { _Pragma("unroll") for (int _i = 0; _i < 2; ++_i) \
        __builtin_amdgcn_global_load_lds((const unsigned*)((const char*)(gbase) + (voff)[_i]), (PG8_LAS unsigned*)(lds + (bufoff) + ldsw + _i * 8192), 16, 0, 0); } while (0)
#define PG8_LDA(dst, b, h) do { _Pragma("unroll") for (int m = 0; m < 4; ++m) _Pragma("unroll") for (int k = 0; k < 2; ++k) dst[m][k] = *(const PG8_LAS bf16x8*)(lds + PG8_SA(b, h) + aoff + m * 2048 + k * 1024); } while (0)
#define PG8_LDB(dst, b, h) do { _Pragma("unroll") for (int n = 0; n < 2; ++n) _Pragma("unroll") for (int k = 0; k < 2; ++k) dst[n][k] = *(const PG8_LAS bf16x8*)(lds + PG8_SB(b, h) + boff + n * 2048 + k * 1024); } while (0)
#define PG8_MMA(ai, bj, At, Bt) do { __builtin_amdgcn_s_setprio(1); _Pragma("unroll") for (int m = 0; m < 4; ++m) _Pragma("unroll") for (int n = 0; n < 2; ++n) _Pragma("unroll") for (int k = 0; k < 2; ++k) \
        acc[ai][bj][m][n] = __builtin_amdgcn_mfma_f32_16x16x32_bf16(Bt[n][k], At[m][k], acc[ai][bj][m][n], 0, 0, 0); __builtin_amdgcn_s_setprio(0); } while (0)
#define PG8_WAIT_V(n) asm volatile("s_waitcnt vmcnt(" #n ")" ::: "memory")
#define PG8_WAIT_L(n) asm volatile("s_waitcnt lgkmcnt(" #n ")" ::: "memory")
#define PG8_BAR __builtin_amdgcn_s_barrier()
#define PG8_SCHED __builtin_amdgcn_sched_barrier(0)
    Unit cur, nxt; int ui = 0;
    if (!S.next(0, cur)) return;
    f32x4 acc[2][2][4][2];
#pragma unroll
    for (int a = 0; a < 2; ++a)
#pragma unroll
        for (int b = 0; b < 2; ++b)
#pragma unroll
            for (int m = 0; m < 4; ++m)
#pragma unroll
                for (int n = 0; n < 2; ++n) acc[a][b][m][n] = (f32x4){0.f, 0.f, 0.f, 0.f};
    bf16x8 At[4][2], B0[2][2], B1[2][2];
    const char* cA = (const char*)g.A + (size_t)cur.pm * tstep; const char* cB = (const char*)g.Bt + (size_t)cur.pn * tstep;
    S.a_ready(cur);
    if constexpr (SP2) {
        PG8_STAGE(PG8_SB(0, 0), cB, voffB); PG8_STAGE(PG8_SB(0, 1), cB + hstep, voffB); PG8_STAGE(PG8_SA(0, 0), cA, voffA); PG8_STAGE(PG8_SA(0, 1), cA + hstep, voffA);
        if (wr == 1) PG8_BAR;
        PG8_WAIT_V(2); PG8_BAR;
        PG8_STAGE(PG8_SB(1, 0), cB + kstep, voffB); PG8_STAGE(PG8_SA(1, 0), cA + kstep, voffA); PG8_STAGE(PG8_SB(1, 1), cB + hstep + kstep, voffB);
        PG8_WAIT_V(6); PG8_BAR;
    } else {
        PG8_STAGE(PG8_SB(0, 0), cB, voffB); PG8_STAGE(PG8_SA(0, 0), cA, voffA); PG8_STAGE(PG8_SB(0, 1), cB + hstep, voffB); PG8_STAGE(PG8_SA(0, 1), cA + hstep, voffA);
        if (wr == 1) PG8_BAR;
        PG8_WAIT_V(4); PG8_BAR;
        PG8_STAGE(PG8_SB(1, 0), cB + kstep, voffB); PG8_STAGE(PG8_SA(1, 0), cA + kstep, voffA); PG8_STAGE(PG8_SB(1, 1), cB + hstep + kstep, voffB);
        PG8_WAIT_V(6); PG8_BAR;
    }
    for (;;) {
        const bool has_next = S.next(ui + 1, nxt);
        const char* nA = has_next ? (const char*)g.A + (size_t)nxt.pm * tstep : cA; const char* nB = has_next ? (const char*)g.Bt + (size_t)nxt.pn * tstep : cB;
        for (int t = 0; t < nt; t += 2) {
            const bool last = (t == nt - 2);
            const char* a1 = cA + (size_t)(t + 1) * kstep;
            const char* a2 = last ? nA : cA + (size_t)(t + 2) * kstep; const char* b2 = last ? nB : cB + (size_t)(t + 2) * kstep;
            const char* a3 = a2 + kstep; const char* b3 = b2 + kstep;
            if (last && has_next) S.a_ready(nxt);
            if constexpr (SP2) {
            PG8_LDB(B0, 0, 0); PG8_LDB(B1, 0, 1); PG8_SCHED; PG8_LDA(At, 0, 0); PG8_STAGE(PG8_SA(1, 1), a1 + hstep, voffA);
            PG8_WAIT_V(8); PG8_WAIT_L(0); PG8_BAR; PG8_MMA(0, 0, At, B0); PG8_MMA(0, 1, At, B1); PG8_BAR; PG8_SCHED;
            PG8_LDA(At, 0, 1); PG8_STAGE(PG8_SB(0, 0), b2, voffB); PG8_STAGE(PG8_SB(0, 1), b2 + hstep, voffB); PG8_STAGE(PG8_SA(0, 0), a2, voffA);
            PG8_WAIT_V(8); PG8_WAIT_L(0); PG8_BAR; PG8_MMA(1, 0, At, B0); PG8_MMA(1, 1, At, B1); PG8_BAR; PG8_SCHED;
            PG8_LDB(B0, 1, 0); PG8_LDB(B1, 1, 1); PG8_SCHED; PG8_LDA(At, 1, 0); PG8_STAGE(PG8_SA(0, 1), a2 + hstep, voffA);
            PG8_WAIT_V(8); PG8_WAIT_L(0); PG8_BAR; PG8_MMA(0, 0, At, B0); PG8_MMA(0, 1, At, B1); PG8_BAR; PG8_SCHED;
            PG8_LDA(At, 1, 1); PG8_STAGE(PG8_SB(1, 0), b3, voffB); PG8_STAGE(PG8_SB(1, 1), b3 + hstep, voffB); PG8_STAGE(PG8_SA(1, 0), a3, voffA);
            PG8_WAIT_V(8); PG8_WAIT_L(0); PG8_BAR; PG8_MMA(1, 0, At, B0); PG8_MMA(1, 1, At, B1); PG8_BAR; PG8_SCHED;
            } else {
            PG8_LDB(B0, 0, 0); PG8_SCHED; PG8_LDA(At, 0, 0); PG8_STAGE(PG8_SA(1, 1), a1 + hstep, voffA);
            PG8_WAIT_L(8); PG8_BAR; PG8_WAIT_L(0); PG8_MMA(0, 0, At, B0); PG8_BAR; PG8_SCHED;
            PG8_LDB(B1, 0, 1); PG8_STAGE(PG8_SB(0, 0), b2, voffB);
            PG8_BAR; PG8_WAIT_L(0); PG8_MMA(0, 1, At, B1); PG8_BAR;
            PG8_LDA(At, 0, 1); PG8_STAGE(PG8_SA(0, 0), a2, voffA);
            PG8_BAR; PG8_WAIT_L(0); PG8_MMA(1, 0, At, B0); PG8_BAR; PG8_SCHED;
            PG8_STAGE(PG8_SB(0, 1), b2 + hstep, voffB);
            PG8_WAIT_V(6); PG8_BAR; PG8_MMA(1, 1, At, B1); PG8_BAR;
            PG8_LDB(B0, 1, 0); PG8_SCHED; PG8_LDA(At, 1, 0); PG8_STAGE(PG8_SA(0, 1), a2 + hstep, voffA);
            PG8_WAIT_L(8); PG8_BAR; PG8_WAIT_L(0); PG8_MMA(0, 0, At, B0); PG8_BAR; PG8_SCHED;
            PG8_LDB(B1, 1, 1); PG8_STAGE(PG8_SB(1, 0), b3, voffB);
            PG8_BAR; PG8_WAIT_L(0); PG8_MMA(0, 1, At, B1); PG8_BAR;
            PG8_LDA(At, 1, 1); PG8_STAGE(PG8_SA(1, 0), a3, voffA);
            PG8_BAR; PG8_WAIT_L(0); PG8_MMA(1, 0, At, B0); PG8_BAR; PG8_SCHED;
            PG8_STAGE(PG8_SB(1, 1), b3 + hstep, voffB);
            PG8_WAIT_V(6); PG8_BAR; PG8_MMA(1, 1, At, B1); PG8_BAR;
            }
        }
        if constexpr (ALIGN_EPI) { if (wr == 0) PG8_BAR; }
        if constexpr (!Epi::AFTER_DRAIN) { E(acc, cur, wr, wc, fr, fq); S.done(cur); }
        if (!has_next) break;
#pragma unroll
        for (int a = 0; a < 2; ++a)
#pragma unroll
            for (int b = 0; b < 2; ++b)
#pragma unroll
                for (int m = 0; m < 4; ++m)
#pragma unroll
                    for (int n = 0; n < 2; ++n) acc[a][b][m][n] = (f32x4){0.f, 0.f, 0.f, 0.f};
        cur = nxt; cA = nA; cB = nB; ++ui;
        if constexpr (ALIGN_EPI) { if (wr == 1) PG8_BAR; }
    }
    PG8_WAIT_V(0);
    if constexpr (!ALIGN_EPI) { if (wr == 0) PG8_BAR; }
    PG8_BAR;
    if constexpr (Epi::AFTER_DRAIN) { E.fused(acc, cur, wr, wc, fr, fq, lds, wid, lane); S.done(cur); }
#undef PG8_SA
#undef PG8_SB
#undef PG8_STAGE
#undef PG8_LDA
#undef PG8_LDB
#undef PG8_MMA
#undef PG8_WAIT_V
#undef PG8_WAIT_L
#undef PG8_BAR
#undef PG8_SCHED
}
}


constexpr int NWAVES = 8;
constexpr int D = 1024, BP = 8, TP = 2048, BS = 128, TS = 8, MP = BP * TP, MS = BS * TS, M = MP + MS, NIN = 2048, FF = 4096, NL = 2;
constexpr int NMODROW = 256, NMOD = 6144, MODLD = NL * NMOD;
constexpr float LN_EPS = 1e-5f;
constexpr float DN_ALPHA = 1.41421356237309515f;
constexpr size_t O_YP = 0, O_YS = (size_t)MP * D, O_CP = O_YS + (size_t)MS * D, O_PP = O_CP + (size_t)NL * BP * 2 * 256, O_CS = O_PP + (size_t)NL * BP * 15 * 256,
                 O_PS = O_CS + (size_t)NL * BS * 2 * 256, O_VS = O_PS + (size_t)NL * BS * 15 * 256, O_END = O_VS + (size_t)NL * BS * TS * 512;
constexpr size_t MiB = 1u << 20;
constexpr size_t WS_CTL = 0, CTL_ZERO_BYTES = 1 * MiB;
constexpr size_t WS_WIN = 2 * MiB, WS_WOUT = 10 * MiB, WS_WUP = 14 * MiB, WS_WDN = 30 * MiB;
constexpr size_t WS_MOD = 46 * MiB, WS_X = 58 * MiB, WS_HA = 60 * MiB, WS_BIG = 94 * MiB;
constexpr size_t WS_PROJ = WS_BIG, WS_MIX = WS_BIG + 68 * MiB, WS_HID = WS_BIG;
constexpr size_t WS_WADA = WS_BIG, WS_AC = WS_BIG + 24 * MiB;
constexpr size_t WS_END = WS_BIG + 136 * MiB;
static_assert(WS_END <= 256 * MiB, "d_ws map");
constexpr int CW_TMO = 0, CW_CODE = 1, CW_BAR = 4096;

constexpr int RING_OFF = 0, RING_BYTES = 131072, LDSCTL_OFF = RING_BYTES, MISC_OFF = LDSCTL_OFF + 320, LDS_BYTES = 147456;

#define GAS __attribute__((address_space(1)))
#define LAS __attribute__((address_space(3)))
typedef unsigned short bf16;
typedef unsigned v4u __attribute__((ext_vector_type(4)));
typedef unsigned v2u __attribute__((ext_vector_type(2)));
typedef float f32x4 __attribute__((ext_vector_type(4)));
typedef GAS unsigned gu32;
#define RLX_AGENT __ATOMIC_RELAXED, __HIP_MEMORY_SCOPE_AGENT
#define LDS_WAIT() asm volatile("s_waitcnt lgkmcnt(0)" ::: "memory")
#define VM_WAIT() asm volatile("s_waitcnt vmcnt(0)" ::: "memory")
__device__ __forceinline__ unsigned f2bf(float f) { unsigned u = __builtin_bit_cast(unsigned, f); return (u + 0x7fffu + ((u >> 16) & 1u)) >> 16; }
__device__ __forceinline__ unsigned pk2(float lo, float hi) { return f2bf(lo) | (f2bf(hi) << 16); }
__device__ __forceinline__ float bflo(unsigned w) { return __builtin_bit_cast(float, w << 16); }
__device__ __forceinline__ float bfhi(unsigned w) { return __builtin_bit_cast(float, w & 0xffff0000u); }
__device__ __forceinline__ float bf1(bf16 h) { return __builtin_bit_cast(float, (unsigned)h << 16); }

#define XB_TMO      128
#define XB_XCNT(j)  (256  + 64 * (j))
#define XB_XSUB(j)  (1280 + 64 * (j))
#define XB_XGEN(j)  (2304 + 64 * (j))
#define XB_TOP      3328
#define XB_TOPGEN   3392
#define XCD_BAR_WORDS 3456
#define XB_SPIN_CAP (1u << 18)

__device__ __forceinline__ unsigned xb_ld(unsigned* p)              { return __hip_atomic_load(p, __ATOMIC_RELAXED, __HIP_MEMORY_SCOPE_AGENT); }
__device__ __forceinline__ unsigned xb_add(unsigned* p, unsigned v) { return __hip_atomic_fetch_add(p, v, __ATOMIC_RELAXED, __HIP_MEMORY_SCOPE_AGENT); }
__device__ __forceinline__ unsigned xb_xcc_id() { return (unsigned)__builtin_amdgcn_s_getreg((3 << 11) | 20) & 0xFu; }
#define XB_SPIN(cond, bar) do { unsigned _sp = 0; while (cond) { __builtin_amdgcn_s_sleep(1); \
    if ((++_sp & 255u) == 0u) { if (xb_ld(&(bar)[XB_TMO])) break; if (_sp > XB_SPIN_CAP) { atomicAdd(&(bar)[XB_TMO], 1u); break; } } } } while (0)

struct XcdBarrier {
    unsigned* bar; unsigned x;
    volatile LAS unsigned* st;
};

__device__ __forceinline__ XcdBarrier xcd_barrier_post(unsigned* bar, volatile LAS unsigned* st) {
    XcdBarrier b; b.bar = bar; b.x = xb_xcc_id(); b.st = st;
    if (threadIdx.x == 0) (void)xb_add(&bar[XB_XCNT(b.x)], 1u);
    return b;
}
__device__ __forceinline__ void xcd_barrier_complete(unsigned* bar, unsigned x, unsigned& nloc, unsigned& nx) {
    const unsigned G = gridDim.x * gridDim.y * gridDim.z;
    unsigned sum, cnt, mine, sp = 0u;
    for (;;) {
        sum = 0u; cnt = 0u; mine = 0u;
#pragma unroll
        for (unsigned j = 0; j < 16; ++j) { const unsigned c = xb_ld(&bar[XB_XCNT(j)]); sum += c; cnt += (c > 0u) ? 1u : 0u; mine = (j == x) ? c : mine; }
        if (sum == G) break;
        __builtin_amdgcn_s_sleep(1);
        if ((++sp & 255u) == 0u) { if (xb_ld(&bar[XB_TMO])) break; if (sp > XB_SPIN_CAP) { atomicAdd(&bar[XB_TMO], 1u); break; } }
    }
    nloc = mine > 0u ? mine : 1u; nx = cnt > 0u ? cnt : 1u;
}

__device__ __forceinline__ void xcd_barrier(const XcdBarrier& b) {
    asm volatile("s_waitcnt vmcnt(0)" ::: "memory");
    __syncthreads();
    if (threadIdx.x == 0) {
        unsigned* bar = b.bar;
        __builtin_amdgcn_s_waitcnt(0);
        unsigned nloc = b.st[0], nx = b.st[1];
        if (nloc == 0u) { xcd_barrier_complete(bar, b.x, nloc, nx); b.st[0] = nloc; b.st[1] = nx; }
        const unsigned old = xb_add(&bar[XB_XSUB(b.x)], 1u);
        const unsigned gen = old / nloc;
        if (old + 1u == (gen + 1u) * nloc) {
            __builtin_amdgcn_fence(__ATOMIC_RELEASE, "agent");
            asm volatile("s_waitcnt vmcnt(0)" ::: "memory");
            const unsigned og = xb_add(&bar[XB_TOP], 1u);
            const unsigned tg = og / nx;
            if (og + 1u == (tg + 1u) * nx) xb_add(&bar[XB_TOPGEN], 1u);
            else XB_SPIN(xb_ld(&bar[XB_TOPGEN]) == tg, bar);
            __builtin_amdgcn_fence(__ATOMIC_ACQUIRE, "agent");
            xb_add(&bar[XB_XGEN(b.x)], 1u);
            asm volatile("s_waitcnt vmcnt(0)" ::: "memory");
        } else {
            XB_SPIN(xb_ld(&bar[XB_XGEN(b.x)]) == gen, bar);
            __builtin_amdgcn_fence(__ATOMIC_ACQUIRE, "agent");
            asm volatile("s_waitcnt vmcnt(0)" ::: "memory");
        }
    }
    __syncthreads();
}


struct Args { const float* in[23]; float* out; unsigned char* ws; int ph_lo, ph_hi; };
struct Frame {
    LAS unsigned char* lds; volatile LAS unsigned* MISC; gu32* ctl;
    int tid, lane, wave, vcu, G;
};
__device__ __forceinline__ float wave_sum(float v) {
#pragma unroll
    for (int o = 1; o < 64; o <<= 1) v += __shfl_xor(v, o);
    return v;
}
__device__ __forceinline__ int mod_row(int r) { return r < MP ? (r >> 11) : BP + ((r - MP) >> 3); }

__device__ __forceinline__ void p0_transpose_item(const float* W, int K, int N, bf16* WT, int row_off, LAS float* scr, int item, int lane) {
    const int nblk = N / 32, kb = item / nblk, nb = item % nblk, k0 = 64 * kb, n0 = 32 * nb;
#pragma unroll 8
    for (int i = 0; i < 32; ++i) { const int kk = 2 * i + (lane >> 5); scr[kk * 33 + (lane & 31)] = W[(size_t)(k0 + kk) * N + n0 + (lane & 31)]; }
    LDS_WAIT(); asm volatile("" ::: "memory");
    const int c = lane & 7;
#pragma unroll
    for (int j = 0; j < 4; ++j) { const int n = (lane >> 3) + 8 * j; const LAS float* s = scr + (8 * c) * 33 + n;
        v4u o; o.x = pk2(s[0 * 33], s[1 * 33]); o.y = pk2(s[2 * 33], s[3 * 33]); o.z = pk2(s[4 * 33], s[5 * 33]); o.w = pk2(s[6 * 33], s[7 * 33]);
        *(GAS v4u*)(WT + (size_t)(row_off + n0 + n) * K + k0 + 8 * c) = o; }
    LDS_WAIT(); asm volatile("" ::: "memory");
}

__device__ __forceinline__ void p0_prologue(Frame& F, const Args& a) {
    LAS float* scr = (LAS float*)(F.lds + RING_OFF + F.wave * 16384);
    const int gw = F.vcu * NWAVES + F.wave, NGW = F.G * NWAVES;
    unsigned char* ws = a.ws;
    constexpr int I_IN = (D / 64) * (NIN / 32), I_OUT = (D / 64) * (D / 32), I_UP = (D / 64) * (FF / 32), I_DN = (FF / 64) * (D / 32), I_ADA = (D / 64) * (NMOD / 32);
    constexpr int PER_L = I_IN + I_OUT + I_UP + I_DN + I_ADA, NITEMS = NL * PER_L;
    for (int it = gw; it < NITEMS; it += NGW) {
        const int l = it / PER_L; int r = it % PER_L;
        if (r < I_ADA) { p0_transpose_item(a.in[6] + (size_t)l * D * NMOD, D, NMOD, (bf16*)(ws + WS_WADA), l * NMOD, scr, r, F.lane); continue; } r -= I_ADA;
        if (r < I_IN) { p0_transpose_item(a.in[8] + (size_t)l * D * NIN, D, NIN, (bf16*)(ws + WS_WIN) + (size_t)l * NIN * D, 0, scr, r, F.lane); continue; } r -= I_IN;
        if (r < I_OUT) { p0_transpose_item(a.in[16] + (size_t)l * D * D, D, D, (bf16*)(ws + WS_WOUT) + (size_t)l * D * D, 0, scr, r, F.lane); continue; } r -= I_OUT;
        if (r < I_UP) { p0_transpose_item(a.in[19] + (size_t)l * D * FF, D, FF, (bf16*)(ws + WS_WUP) + (size_t)l * FF * D, 0, scr, r, F.lane); continue; } r -= I_UP;
        p0_transpose_item(a.in[20] + (size_t)l * FF * D, FF, D, (bf16*)(ws + WS_WDN) + (size_t)l * D * FF, 0, scr, r, F.lane);
    }
    bf16* AC = (bf16*)(ws + WS_AC);
    for (int m = gw; m < NMODROW; m += NGW) {
        GAS unsigned long long* o8 = (GAS unsigned long long*)(AC + (size_t)m * D) + F.lane;
        if (m < BP + BS) { const float* crow = m < BP ? a.in[2] + (size_t)m * D : a.in[3] + (size_t)(m - BP) * D;
            const GAS f32x4* xr = (const GAS f32x4*)crow + F.lane;
#pragma unroll
            for (int j = 0; j < 4; ++j) { f32x4 v = xr[64 * j];
#pragma unroll
                for (int e = 0; e < 4; ++e) v[e] = v[e] / (1.0f + __expf(-v[e]));
                o8[64 * j] = (unsigned long long)pk2(v.x, v.y) | ((unsigned long long)pk2(v.z, v.w) << 32); }
        } else {
#pragma unroll
            for (int j = 0; j < 4; ++j) o8[64 * j] = 0ull; }
    }
}

__device__ __forceinline__ void modulate_rows(Frame& F, const float* xp, const float* xs, const float* mod_sh, const float* mod_sc, bf16* hb) {
    const int gw = F.vcu * NWAVES + F.wave, NGW = F.G * NWAVES;
    for (int r = gw; r < M; r += NGW) {
        const float* xrow = r < MP ? xp + (size_t)r * D : xs + (size_t)(r - MP) * D; const int mr = mod_row(r);
        const GAS f32x4* xr = (const GAS f32x4*)xrow + F.lane; const GAS f32x4* sh = (const GAS f32x4*)(mod_sh + (size_t)mr * MODLD) + F.lane; const GAS f32x4* sc = (const GAS f32x4*)(mod_sc + (size_t)mr * MODLD) + F.lane;
        GAS unsigned long long* o8 = (GAS unsigned long long*)(hb + (size_t)r * D) + F.lane;
#pragma unroll
        for (int j = 0; j < 4; ++j) { const f32x4 v = xr[64 * j], a = sh[64 * j], b = sc[64 * j]; const f32x4 h = v * (b + 1.0f) + a;
            o8[64 * j] = (unsigned long long)pk2(h.x, h.y) | ((unsigned long long)pk2(h.z, h.w) << 32); }
    }
}
__device__ __forceinline__ void ln_rows(Frame& F, float* x, const float* g, const float* b, const float* mod_sh, const float* mod_sc, bf16* hb) {
    const int gw = F.vcu * NWAVES + F.wave, NGW = F.G * NWAVES;
    for (int r = gw; r < M; r += NGW) {
        GAS f32x4* xr = (GAS f32x4*)(x + (size_t)r * D) + F.lane; const int mr = mod_row(r);
        f32x4 v[4]; float s = 0.f;
#pragma unroll
        for (int j = 0; j < 4; ++j) { v[j] = xr[64 * j]; s += (v[j].x + v[j].y) + (v[j].z + v[j].w); }
        const float mean = wave_sum(s) * (1.f / D); float s2 = 0.f;
#pragma unroll
        for (int j = 0; j < 4; ++j) { v[j] = v[j] - mean; s2 += (v[j].x * v[j].x + v[j].y * v[j].y) + (v[j].z * v[j].z + v[j].w * v[j].w); }
        const float rstd = 1.f / sqrtf(wave_sum(s2) * (1.f / D) + LN_EPS);
#pragma unroll
        for (int j = 0; j < 4; ++j) { const f32x4 gg = ((const GAS f32x4*)g)[F.lane + 64 * j], bb = ((const GAS f32x4*)b)[F.lane + 64 * j]; v[j] = v[j] * rstd * gg + bb; xr[64 * j] = v[j]; }
        if (hb) { const GAS f32x4* sh = (const GAS f32x4*)(mod_sh + (size_t)mr * MODLD) + F.lane; const GAS f32x4* sc = (const GAS f32x4*)(mod_sc + (size_t)mr * MODLD) + F.lane;
            GAS unsigned long long* o8 = (GAS unsigned long long*)(hb + (size_t)r * D) + F.lane;
#pragma unroll
            for (int j = 0; j < 4; ++j) { const f32x4 h = v[j] * (sc[64 * j] + 1.0f) + sh[64 * j]; o8[64 * j] = (unsigned long long)pk2(h.x, h.y) | ((unsigned long long)pk2(h.z, h.w) << 32); } }
    }
}

__device__ __forceinline__ void unpack4(v2u w, float (&f)[4]) { f[0] = bflo(w.x); f[1] = bfhi(w.x); f[2] = bflo(w.y); f[3] = bfhi(w.y); }

__device__ __forceinline__ void conv_phase(Frame& F, const Args& a, int l, const bf16* proj, bf16* mix) {
    const int gt = F.vcu * (NWAVES * 64) + F.tid, NGT = F.G * NWAVES * 64;
    const float* cw = a.in[9] + (size_t)l * 3 * 256;
    for (int it = gt; it < (M / 8) * 64; it += NGT) {
        const int cg = it & 63, tg = it >> 6, r0 = tg * 8, c = cg * 4; const bool samp = r0 >= MP;
        const int t0 = samp ? 0 : (r0 & (TP - 1)); const int sb = samp ? (r0 - MP) >> 3 : (r0 >> 11);
        float zm2[4] = {0.f, 0.f, 0.f, 0.f}, zm1[4] = {0.f, 0.f, 0.f, 0.f};
        if (samp) { const float* st = a.in[4] + ((size_t)(l * BS + sb) * 2) * 256 + c; const f32x4 s0 = *(const f32x4*)st, s1 = *(const f32x4*)(st + 256);
#pragma unroll
            for (int e = 0; e < 4; ++e) { zm2[e] = s0[e]; zm1[e] = s1[e]; } }
        else if (t0 != 0) { float p[4], q[4];
            unpack4(*(const v2u*)(proj + (size_t)(r0 - 2) * NIN + 256 + c), p); unpack4(*(const v2u*)(proj + (size_t)(r0 - 2) * NIN + 512 + c), q);
#pragma unroll
            for (int e = 0; e < 4; ++e) zm2[e] = p[e] * q[e];
            unpack4(*(const v2u*)(proj + (size_t)(r0 - 1) * NIN + 256 + c), p); unpack4(*(const v2u*)(proj + (size_t)(r0 - 1) * NIN + 512 + c), q);
#pragma unroll
            for (int e = 0; e < 4; ++e) zm1[e] = p[e] * q[e]; }
        const f32x4 w0 = *(const f32x4*)(cw + c), w1 = *(const f32x4*)(cw + 256 + c), w2 = *(const f32x4*)(cw + 512 + c);
        const bool last_p = (!samp) && (t0 + 8 == TP);
#pragma unroll
        for (int tt = 0; tt < 8; ++tt) { const size_t ro = (size_t)(r0 + tt) * NIN; float ab[4], ac[4], ax[4], z[4], y[4];
            unpack4(*(const v2u*)(proj + ro + c), ab); unpack4(*(const v2u*)(proj + ro + 256 + c), ac); unpack4(*(const v2u*)(proj + ro + 512 + c), ax);
#pragma unroll
            for (int e = 0; e < 4; ++e) { z[e] = ac[e] * ax[e]; y[e] = ab[e] * (zm2[e] * w0[e] + zm1[e] * w1[e] + z[e] * w2[e]); zm2[e] = zm1[e]; zm1[e] = z[e]; }
            v2u o; o.x = pk2(y[0], y[1]); o.y = pk2(y[2], y[3]); *(v2u*)(mix + (size_t)(r0 + tt) * D + c) = o;
            if (tt >= 6) { const f32x4 zz = {z[0], z[1], z[2], z[3]};
                if (samp) *(f32x4*)(a.out + O_CS + ((size_t)(l * BS + sb) * 2 + (tt - 6)) * 256 + c) = zz;
                else if (last_p) *(f32x4*)(a.out + O_CP + ((size_t)(l * BP + sb) * 2 + (tt - 6)) * 256 + c) = zz; }
        }
    }
}

template <int W> __device__ __forceinline__ void pool_item(Frame& F, const Args& a, int l, const bf16* proj, bf16* mix, int tg, int g) {
    const int lane = F.lane, ch = g * 64 + lane, r0 = tg * 8; const bool samp = r0 >= MP;
    const int t0 = samp ? 0 : (r0 & (TP - 1)); const int sb = samp ? (r0 - MP) >> 3 : (r0 >> 11);
    float e[W - 1 + 8];
#pragma unroll
    for (int k = -(W - 1); k < 8; ++k) { float v;
        if (k >= 0) v = bf1(proj[(size_t)(r0 + k) * NIN + 1792 + ch]);
        else if (samp) v = a.in[5][((size_t)(l * BS + sb) * 15 + (15 + k)) * 256 + ch];
        else v = (t0 + k >= 0) ? bf1(proj[(size_t)(r0 + k) * NIN + 1792 + ch]) : 0.f;
        e[k + W - 1] = v; }
    float d[8];
#pragma unroll
    for (int tt = 0; tt < 8; ++tt) { float s = 0.f;
#pragma unroll
        for (int i = 0; i < W; ++i) s += e[tt - i + W - 1];
        const int cnt = samp ? W : ((t0 + tt + 1) < W ? (t0 + tt + 1) : W);
        d[tt] = s / (float)cnt - e[tt + W - 1]; }
    float acc[8] = {0.f, 0.f, 0.f, 0.f, 0.f, 0.f, 0.f, 0.f};
    const float* pw = a.in[14] + ((size_t)(l * 4 + g) * 64) * 64 + lane;
    for (int c = 0; c < 64; ++c) { const float w = pw[(size_t)c * 64];
#pragma unroll
        for (int tt = 0; tt < 8; ++tt) acc[tt] += __builtin_bit_cast(float, __builtin_amdgcn_readlane(__builtin_bit_cast(int, d[tt]), c)) * w; }
    const float ps = a.in[15][l * 256 + ch];
#pragma unroll
    for (int tt = 0; tt < 8; ++tt) mix[(size_t)(r0 + tt) * D + 768 + ch] = (bf16)f2bf(acc[tt] * ps);
    if (samp) { float* o = a.out + O_PS + ((size_t)(l * BS + sb) * 15) * 256 + ch;
#pragma unroll
        for (int j = 0; j < 7; ++j) o[(size_t)j * 256] = a.in[5][((size_t)(l * BS + sb) * 15 + (8 + j)) * 256 + ch];
#pragma unroll
        for (int j = 7; j < 15; ++j) o[(size_t)j * 256] = e[(j - 7) + W - 1];
    } else if (t0 + 8 > TP - 15) { float* o = a.out + O_PP + ((size_t)(l * BP + sb) * 15) * 256 + ch;
#pragma unroll
        for (int tt = 0; tt < 8; ++tt) { const int j = t0 + tt - (TP - 15); if (j >= 0) o[(size_t)j * 256] = e[tt + W - 1]; } }
}
__device__ __forceinline__ void pool_phase(Frame& F, const Args& a, int l, const bf16* proj, bf16* mix) {
    const int gw = F.vcu * NWAVES + F.wave, NGW = F.G * NWAVES;
    for (int it = gw; it < (M / 8) * 4; it += NGW) { const int g = it & 3, tg = it >> 2;
        if (g == 0) pool_item<2>(F, a, l, proj, mix, tg, 0); else if (g == 1) pool_item<4>(F, a, l, proj, mix, tg, 1);
        else if (g == 2) pool_item<8>(F, a, l, proj, mix, tg, 2); else pool_item<16>(F, a, l, proj, mix, tg, 3); }
}

__device__ __forceinline__ void sgu_phase(Frame& F, const Args& a, int l, const bf16* proj, bf16* mix) {
    LAS float* VN = (LAS float*)(F.lds + RING_OFF);
    const float* sg = a.in[10] + l * 512; const float* sbv = a.in[11] + l * 512;
    for (int unit = F.vcu; unit < (M / 128) * 2; unit += F.G) {
        const int hh = unit & 1, ck = unit >> 1, r0 = ck * 128; const bool samp = r0 >= MP;
        for (int i = F.wave * 16; i < F.wave * 16 + 16; ++i) { const int r = r0 + i;
            const v4u raw = *(const v4u*)(proj + (size_t)r * NIN + 1280 + 8 * F.lane);
            float v[8] = {bflo(raw.x), bfhi(raw.x), bflo(raw.y), bfhi(raw.y), bflo(raw.z), bfhi(raw.z), bflo(raw.w), bfhi(raw.w)}; float s = 0.f;
#pragma unroll
            for (int k = 0; k < 8; ++k) s += v[k];
            const float mean = wave_sum(s) * (1.f / 512.f); float s2 = 0.f;
#pragma unroll
            for (int k = 0; k < 8; ++k) { v[k] -= mean; s2 += v[k] * v[k]; }
            const float rstd = 1.f / sqrtf(wave_sum(s2) * (1.f / 512.f) + LN_EPS);
            if ((F.lane >> 5) == hh) { const f32x4 g0 = *(const f32x4*)(sg + 8 * F.lane), g1 = *(const f32x4*)(sg + 8 * F.lane + 4), b0 = *(const f32x4*)(sbv + 8 * F.lane), b1 = *(const f32x4*)(sbv + 8 * F.lane + 4);
                f32x4 o0 = {v[0], v[1], v[2], v[3]}, o1 = {v[4], v[5], v[6], v[7]}; o0 = o0 * rstd * g0 + b0; o1 = o1 * rstd * g1 + b1;
                LAS f32x4* dst = (LAS f32x4*)(VN + i * 256 + 8 * (F.lane & 31)); dst[0] = o0; dst[1] = o1;
                if (samp) { float* vo = a.out + O_VS + ((size_t)l * MS + (r - MP)) * 512 + 8 * F.lane; *(f32x4*)vo = o0; *(f32x4*)(vo + 4) = o1; } }
        }
        LDS_WAIT(); __syncthreads();
        for (int p = F.wave; p < 4 * 128; p += NWAVES) { const int hl = p & 3, i = p >> 2, h = hh * 4 + hl, j0 = samp ? (i & ~7) : 0;
            const float* wrow = a.in[12] + ((size_t)(l * 8 + h) * 128 + (i - j0)) * 128; float acc = 0.f;
            for (int j = j0; j <= i; ++j) acc += wrow[j - j0] * VN[j * 256 + hl * 64 + F.lane];
            const float s = acc + a.in[13][(l * 8 + h) * 128 + (i - j0)];
            const float u = bf1(proj[(size_t)(r0 + i) * NIN + 768 + h * 64 + F.lane]);
            mix[(size_t)(r0 + i) * D + 256 + h * 64 + F.lane] = (bf16)f2bf(u * s); }
        LDS_WAIT(); __syncthreads();
    }
}

constexpr int N_PHASES = 3 + 7 * NL;
__global__ void __launch_bounds__(NWAVES * 64, 2) skel_fwd(Args args) {
    extern __shared__ __attribute__((aligned(16))) unsigned char lds[];
    Frame F;
    F.lds = (LAS unsigned char*)lds; F.MISC = (volatile LAS unsigned*)(F.lds + MISC_OFF);
    F.tid = threadIdx.x; F.lane = F.tid & 63; F.wave = __builtin_amdgcn_readfirstlane(F.tid >> 6);
    F.G = gridDim.x; { const int bx = blockIdx.x; F.vcu = (F.G % 8 == 0) ? (bx % 8) * (F.G / 8) + bx / 8 : bx; }
    unsigned char* ws = args.ws; F.ctl = (gu32*)(ws + WS_CTL);
    for (int u = F.tid; u < (LDS_BYTES - LDSCTL_OFF) / 4; u += NWAVES * 64) ((LAS unsigned*)(F.lds + LDSCTL_OFF))[u] = 0u;
    __syncthreads();
    const int lo = args.ph_lo, hi = args.ph_hi;
    XcdBarrier bar; bar.bar = (unsigned*)(F.ctl + CW_BAR); bar.x = 0; bar.st = nullptr;
    if (hi - lo > 1) bar = xcd_barrier_post((unsigned*)(F.ctl + CW_BAR), F.MISC + 8);
#define IN(k) (lo <= (k) && (k) < hi)
#define FRESH() do { int t_ = threadIdx.x; asm volatile("" : "+v"(t_)); F.tid = t_; F.lane = t_ & 63; } while (0)
#define SEAM(k) do { if (IN(k) && IN((k) + 1)) xcd_barrier(bar); } while (0)
    bf16* const WIN = (bf16*)(ws + WS_WIN); bf16* const WOUT = (bf16*)(ws + WS_WOUT); bf16* const WUP = (bf16*)(ws + WS_WUP); bf16* const WDN = (bf16*)(ws + WS_WDN);
    float* const MOD = (float*)(ws + WS_MOD); bf16* const HA = (bf16*)(ws + WS_HA); bf16* const PROJ = (bf16*)(ws + WS_PROJ); bf16* const MIX = (bf16*)(ws + WS_MIX); bf16* const HID = (bf16*)(ws + WS_HID);
    float* const Y = args.out;

#ifndef DIS_PRO
    if (IN(0)) { FRESH(); p0_prologue(F, args); SEAM(0); }
#endif
    if (IN(1)) {
        pg8::Gemm g{(const bf16*)(ws + WS_AC), (const bf16*)(ws + WS_WADA), NMODROW, MODLD, D}; pg8::StaticOrder S; S.init(NMODROW, MODLD, F.G, (int)blockIdx.x);
        pg8::EpiF32 E{MOD, MODLD, args.in[7]};
        pg8::gemm_phase<pg8::EpiF32, pg8::StaticOrder, true, true>(F.lds + RING_OFF, g, S, E); SEAM(1); }
    if (IN(2)) { FRESH(); modulate_rows(F, args.in[0], args.in[1], MOD + 0, MOD + 1024, HA); SEAM(2); }
#pragma unroll 1
    for (int l = 0; l < NL; ++l) {
        const int pb = 3 + 7 * l; const float* modl = MOD + (size_t)l * NMOD;
        if (IN(pb + 0)) { pg8::Gemm g{HA, WIN + (size_t)l * NIN * D, M, NIN, D}; pg8::StaticOrder S; S.init(M, NIN, F.G, (int)blockIdx.x);
            pg8::EpiBf16<0> E{PROJ, NIN, nullptr, 0, 0, 1.f};
            pg8::gemm_phase<pg8::EpiBf16<0>, pg8::StaticOrder, true, true>(F.lds + RING_OFF, g, S, E); SEAM(pb + 0); }
        if (IN(pb + 1)) {
#ifndef DIS_CONV
 FRESH(); conv_phase(F, args, l, PROJ, MIX);
#endif
#ifndef DIS_POOL
 FRESH(); pool_phase(F, args, l, PROJ, MIX);
#endif
#ifndef DIS_SGU
 FRESH(); sgu_phase(F, args, l, PROJ, MIX);
#endif
 SEAM(pb + 1); }
        if (IN(pb + 2)) { pg8::Gemm g{MIX, WOUT + (size_t)l * D * D, M, D, D}; pg8::StaticOrder S; S.init(M, D, F.G, (int)blockIdx.x);
            pg8::EpiRes E{l == 0 ? args.in[0] : Y, l == 0 ? args.in[1] : Y + (size_t)MP * D, Y, modl + 2048, DN_ALPHA};
            pg8::gemm_phase<pg8::EpiRes, pg8::StaticOrder, true, true>(F.lds + RING_OFF, g, S, E); SEAM(pb + 2); }
        if (IN(pb + 3)) { FRESH(); ln_rows(F, Y, args.in[17] + l * D, args.in[18] + l * D, modl + 3072, modl + 4096, HA); SEAM(pb + 3); }
        if (IN(pb + 4)) { pg8::Gemm g{HA, WUP + (size_t)l * FF * D, M, FF, D}; pg8::StaticOrder S; S.init(M, FF, F.G, (int)blockIdx.x);
            pg8::EpiBf16<2> E{HID, FF, nullptr, 0, 0, 1.f};
            pg8::gemm_phase<pg8::EpiBf16<2>, pg8::StaticOrder, true, true>(F.lds + RING_OFF, g, S, E); SEAM(pb + 4); }
        if (IN(pb + 5)) { pg8::Gemm g{HID, WDN + (size_t)l * D * FF, M, D, FF}; pg8::StaticOrder S; S.init(M, D, F.G, (int)blockIdx.x);
            pg8::EpiRes E{Y, Y + (size_t)MP * D, Y, modl + 5120, DN_ALPHA};
            pg8::gemm_phase<pg8::EpiRes, pg8::StaticOrder, true, true>(F.lds + RING_OFF, g, S, E); SEAM(pb + 5); }
        if (IN(pb + 6)) { FRESH(); const bool more = (l + 1 < NL);
            ln_rows(F, Y, args.in[21] + l * D, args.in[22] + l * D, modl + NMOD + 0, modl + NMOD + 1024, more ? HA : nullptr); SEAM(pb + 6); }
    }
#undef IN
#undef SEAM
}

#ifndef MK_ONE_LAUNCH
#define MK_ONE_LAUNCH 1
#endif
extern "C" void kernel_launch(void* const* d_in, const int* in_sizes, int n_in, void* d_out, int out_size, void* d_ws, size_t ws_size, hipStream_t stream) {
    static int grid = 0;
    if (grid == 0) {
        if (n_in != 23 || (size_t)out_size != O_END || ws_size < WS_END) { fprintf(stderr, "kernel_launch: unexpected shapes: n_in %d out %d ws %zu\n", n_in, out_size, ws_size); grid = -1; return; }
        int dev = 0, cus = 0, per_cu = 0;
        if (hipGetDevice(&dev) != hipSuccess || hipDeviceGetAttribute(&cus, hipDeviceAttributeMultiprocessorCount, dev) != hipSuccess) { grid = -1; return; }
        if (hipFuncSetAttribute((const void*)skel_fwd, hipFuncAttributeMaxDynamicSharedMemorySize, LDS_BYTES) != hipSuccess) { fprintf(stderr, "kernel_launch: hipFuncSetAttribute failed\n"); grid = -1; return; }
        if (hipOccupancyMaxActiveBlocksPerMultiprocessor(&per_cu, (const void*)skel_fwd, NWAVES * 64, LDS_BYTES) != hipSuccess || per_cu < 1) { fprintf(stderr, "kernel_launch: occupancy query says %d\n", per_cu); per_cu = 1; }
        (void)hipGetLastError();
        grid = cus * (per_cu < 1 ? 1 : 1);
    }
    if (grid < 0) return;
    if (hipMemsetAsync((char*)d_ws + WS_CTL, 0, CTL_ZERO_BYTES, stream) != hipSuccess) return;
    Args a{};
    for (int i = 0; i < 23; ++i) a.in[i] = (const float*)d_in[i];
    a.out = (float*)d_out; a.ws = (unsigned char*)d_ws;
#if MK_ONE_LAUNCH
    a.ph_lo = 0; a.ph_hi = N_PHASES;
    void* kargs[] = {(void*)&a};
    hipError_t e = hipLaunchCooperativeKernel((const void*)skel_fwd, dim3(grid), dim3(NWAVES * 64), kargs, LDS_BYTES, stream);
    if (e != hipSuccess) fprintf(stderr, "kernel_launch: cooperative launch failed: %s (grid %d)\n", hipGetErrorString(e), grid);
#else
    for (int p = 0; p < N_PHASES; ++p) { a.ph_lo = p; a.ph_hi = p + 1; hipLaunchKernelGGL(skel_fwd, dim3(grid), dim3(NWAVES * 64), LDS_BYTES, stream, a); }
#endif
}
```

```cpp
#include <hip/hip_runtime.h>
#include <cstdio>
#include <cstdint>
namespace pg8 {
#define PG8_LAS __attribute__((address_space(3)))
typedef unsigned short bf16_t;
typedef short bf16x8 __attribute__((ext_vector_type(8)));
typedef float f32x4 __attribute__((ext_vector_type(4)));
typedef unsigned u32x4 __attribute__((ext_vector_type(4)));
constexpr int BM = 256, BK = 64, HALF = 128, HTB = HALF * BK * 2  , STAGE_BYTES = 8 * HTB, NXCD = 8, WGM = 8;

__host__ __device__ __forceinline__ int lds_byte(int r, int c) { const int st = (r >> 4) * 2 + (c >> 5), rr = r & 15, cc = c & 31, ob = rr * 64 + cc * 2; return st * 1024 + (ob ^ (((ob >> 9) & 1) << 5)); }
__host__ __device__ __forceinline__ void stage_rc(int b, int& R, int& C) { const int st = b / 1024, sb = b % 1024, swz = sb ^ (((sb >> 9) & 1) << 5); R = (st >> 1) * 16 + swz / 64; C = (st & 1) * 32 + (swz % 64) / 2; }
__host__ __device__ __forceinline__ int perm32(int rho) { const int n = rho >> 4, i = rho & 15; return 8 * (i >> 2) + 4 * n + (i & 3); }

struct Unit { int pm, pn; };
struct Gemm { const bf16_t* A; const bf16_t* Bt; int M, N, K; };

struct StaticOrder {
    int nM, nN, nwg, G, c;
    __host__ __device__ void init(int M, int N, int G_, int c_) { nM = M / BM; nN = N / BM; nwg = nM * nN; G = G_; c = c_; }
    __host__ __device__ bool next(int i, Unit& u) const {
        const long L = (long)i * G + c; if (L >= nwg) return false;
        int wgid = (int)L; { const int q = nwg / NXCD, r = nwg % NXCD, xcd = wgid % NXCD, off = wgid / NXCD; wgid = (xcd < r ? xcd * (q + 1) : r * (q + 1) + (xcd - r) * q) + off; }
        const int nig = WGM * nN, gid = wgid / nig, fm = gid * WGM, gsz = (nM - fm) < WGM ? (nM - fm) : WGM;
        u.pm = fm + ((wgid % nig) % gsz); u.pn = (wgid % nig) / gsz; return true;
    }
    __device__ __forceinline__ void a_ready(const Unit&) const {}
    __device__ __forceinline__ void done(const Unit&) const {}
};

__device__ __forceinline__ unsigned cvt_pk_bf16(float lo, float hi) { unsigned r; asm volatile("v_cvt_pk_bf16_f32 %0, %1, %2" : "=v"(r) : "v"(lo), "v"(hi)); return r; }
typedef float f32x2 __attribute__((ext_vector_type(2)));
__device__ __forceinline__ f32x2 gelu_pk(f32x2 v) {
    const f32x2 av = __builtin_elementwise_abs(v), d = av * 0.2316418882f + 1.0f;
    f32x2 t; t.x = __builtin_amdgcn_rcpf(d.x); t.y = __builtin_amdgcn_rcpf(d.y);
    f32x2 q = t * 0.5307027145f + (-0.7265760135f); q = q * t + 0.7107068705f; q = q * t + (-0.142248368f); q = q * t + 0.127414796f; q = q * t;
    const f32x2 s = (v * v) * (-0.72134752044f);
    f32x2 e; e.x = __builtin_amdgcn_exp2f(s.x); e.y = __builtin_amdgcn_exp2f(s.y);
    const f32x2 m = v * (q * e), r = v - m;
    f32x2 o; o.x = v.x < 0.f ? m.x : r.x; o.y = v.y < 0.f ? m.y : r.y; return o;
}

struct EpiF32 {
    static constexpr bool PERM = false, AFTER_DRAIN = false;
    float* C; int ldc; const float* bias;
    __device__ __forceinline__ void operator()(const f32x4 (&acc)[2][2][4][2], const Unit& u, int wr, int wc, int fr, int fq) const {
        const int row0 = u.pm * BM + wr * 64 + fr, col0 = u.pn * BM + wc * 32 + 4 * fq;
        f32x4 bv[2][2];
#pragma unroll
        for (int bj = 0; bj < 2; ++bj)
#pragma unroll
            for (int n = 0; n < 2; ++n) bv[bj][n] = bias ? *(const f32x4*)(bias + col0 + bj * HALF + n * 16) : (f32x4){0.f, 0.f, 0.f, 0.f};
#pragma unroll
        for (int ai = 0; ai < 2; ++ai)
#pragma unroll
            for (int m = 0; m < 4; ++m) { float* rowp = C + (size_t)(row0 + ai * HALF + m * 16) * ldc + col0;
#pragma unroll
                for (int bj = 0; bj < 2; ++bj)
#pragma unroll
                    for (int n = 0; n < 2; ++n) *(f32x4*)(rowp + bj * HALF + n * 16) = acc[ai][bj][m][n] + bv[bj][n]; }
    }
};
template <int ACT  > struct EpiBf16 {
    static constexpr bool PERM = true, AFTER_DRAIN = false; static_assert(ACT == 0 || ACT == 1 || ACT == 2, "EpiBf16: ACT is 0 (none), 1 (gelu_pk) or 2 (squared relu)");
    bf16_t* O; int ldc; const float* bias; int split_cols; size_t split_stride; float scale0;
    __device__ __forceinline__ void operator()(const f32x4 (&acc)[2][2][4][2], const Unit& u, int wr, int wc, int fr, int fq) const {
        const int row0 = u.pm * BM + wr * 64 + fr; int colt = u.pn * BM; bf16_t* base = O;
        float sc = 1.f; if (split_cols) { const int t = colt / split_cols; base += (size_t)t * split_stride; colt -= t * split_cols; if (t == 0) sc = scale0; }
        const int col0 = colt + wc * 32 + 8 * fq, bcol0 = u.pn * BM + wc * 32 + 8 * fq;
        f32x4 bv[2][2];
#pragma unroll
        for (int bj = 0; bj < 2; ++bj)
#pragma unroll
            for (int n = 0; n < 2; ++n) bv[bj][n] = bias ? *(const f32x4*)(bias + bcol0 + bj * HALF + 4 * n) : (f32x4){0.f, 0.f, 0.f, 0.f};
#pragma unroll
        for (int ai = 0; ai < 2; ++ai)
#pragma unroll
            for (int m = 0; m < 4; ++m) { bf16_t* rowp = base + (size_t)(row0 + ai * HALF + m * 16) * ldc + col0;
#pragma unroll
                for (int bj = 0; bj < 2; ++bj) { f32x4 v0 = acc[ai][bj][m][0] + bv[bj][0], v1 = acc[ai][bj][m][1] + bv[bj][1];
                    if (ACT == 1) { f32x2 a = gelu_pk((f32x2){v0[0], v0[1]}), b = gelu_pk((f32x2){v0[2], v0[3]}), c = gelu_pk((f32x2){v1[0], v1[1]}), d = gelu_pk((f32x2){v1[2], v1[3]});
                        v0 = (f32x4){a.x, a.y, b.x, b.y}; v1 = (f32x4){c.x, c.y, d.x, d.y}; }
                    if (ACT == 2) { v0 = __builtin_elementwise_max(v0, (f32x4){0.f, 0.f, 0.f, 0.f}); v1 = __builtin_elementwise_max(v1, (f32x4){0.f, 0.f, 0.f, 0.f}); v0 = v0 * v0; v1 = v1 * v1; }
                    v0 = v0 * sc; v1 = v1 * sc; u32x4 w; w.x = cvt_pk_bf16(v0[0], v0[1]); w.y = cvt_pk_bf16(v0[2], v0[3]); w.z = cvt_pk_bf16(v1[0], v1[1]); w.w = cvt_pk_bf16(v1[2], v1[3]);
                    *(u32x4*)(rowp + bj * HALF) = w; } }
    }
};

struct PanelStats {
    unsigned* xbuf;
    unsigned* cnt;
    unsigned* tmo;
    int ntn; float eps;
    unsigned code;
    __device__ __forceinline__ bool run(const f32x4 (&v)[2][2][4][2], const Unit& u, int wr, int wc, int fr, int fq, PG8_LAS unsigned char* lds, int wid, int lane) const {
        typedef float f32x2v __attribute__((ext_vector_type(2)));
        PG8_LAS f32x2v* P = (PG8_LAS f32x2v*)lds;
        PG8_LAS f32x2v* S = (PG8_LAS f32x2v*)(lds + 8192);
        PG8_LAS unsigned* flag = (PG8_LAS unsigned*)(lds + 8192 + 2048);
#pragma unroll
        for (int ai = 0; ai < 2; ++ai)
#pragma unroll
            for (int m = 0; m < 4; ++m) {
                float s = 0.f;
#pragma unroll
                for (int bj = 0; bj < 2; ++bj)
#pragma unroll
                    for (int n = 0; n < 2; ++n) { const f32x4 x = v[ai][bj][m][n]; s += (x[0] + x[1]) + (x[2] + x[3]); }
                s += __shfl_xor(s, 16); s += __shfl_xor(s, 32);
                const float mw = s * (1.0f / 64.0f); float q = 0.f;
#pragma unroll
                for (int bj = 0; bj < 2; ++bj)
#pragma unroll
                    for (int n = 0; n < 2; ++n) { const f32x4 d = v[ai][bj][m][n] - mw; q += (d[0] * d[0] + d[1] * d[1]) + (d[2] * d[2] + d[3] * d[3]); }
                q += __shfl_xor(q, 16); q += __shfl_xor(q, 32);
                if (fq == 0) P[(ai * HALF + wr * 64 + m * 16 + fr) * 4 + wc] = (f32x2v){mw, q};
            }
        asm volatile("s_waitcnt lgkmcnt(0)" ::: "memory"); __builtin_amdgcn_s_barrier(); asm volatile("" ::: "memory");
#if defined(BROKEN_EXCHANGE_NO_WAIT)
#warning BROKEN CONTROL BUILD: the row-statistics exchange does not wait; results are wrong by design
        if (blockIdx.x >= 64) { const long long t0_ = clock64(); while (clock64() - t0_ < 60000) __builtin_amdgcn_s_sleep(8); }
#endif
        const int row = wid * 32 + (lane & 31);
        if (lane < 32) {
            const f32x2v a = P[row * 4 + 0], b = P[row * 4 + 1], c = P[row * 4 + 2], d = P[row * 4 + 3];
            const float mt = (a.x + b.x + c.x + d.x) * 0.25f;
            const float da = a.x - mt, db = b.x - mt, dc = c.x - mt, dd = d.x - mt;
            const float m2 = (a.y + b.y) + (c.y + d.y) + 64.0f * ((da * da + db * db) + (dc * dc + dd * dd));
            unsigned long long* slot = (unsigned long long*)xbuf + ((size_t)(u.pm * BM + row) * 4 + u.pn);
            __hip_atomic_store(slot, ((unsigned long long)__float_as_uint(m2) << 32) | __float_as_uint(mt), __ATOMIC_RELAXED, __HIP_MEMORY_SCOPE_AGENT);
        }
        asm volatile("s_waitcnt vmcnt(0)" ::: "memory");
        if (lane == 0) __hip_atomic_fetch_add(cnt + 64 * u.pm, 1u, __ATOMIC_RELAXED, __HIP_MEMORY_SCOPE_AGENT);
        if (wid == 0) {
            bool dead = false; const unsigned long long t0 = __builtin_amdgcn_s_memrealtime(); const unsigned want = 8u * (unsigned)ntn;
            for (;;) {
#if defined(BROKEN_EXCHANGE_NO_WAIT)
                break;
#endif
                if ((unsigned)__builtin_amdgcn_readfirstlane(__hip_atomic_load(cnt + 64 * u.pm, __ATOMIC_RELAXED, __HIP_MEMORY_SCOPE_AGENT)) >= want) break;
                if (__builtin_amdgcn_s_memrealtime() - t0 > 2000000ull) {
                    if (lane == 0) { unsigned expect = 0u; __hip_atomic_compare_exchange_strong(tmo + 1, &expect, code | (unsigned)(u.pm & 0xff), __ATOMIC_RELAXED, __ATOMIC_RELAXED, __HIP_MEMORY_SCOPE_AGENT);
                                     __hip_atomic_store(tmo, 1u, __ATOMIC_RELAXED, __HIP_MEMORY_SCOPE_AGENT); }
                    dead = true; break; }
                __builtin_amdgcn_s_sleep(2);
            }
            __builtin_amdgcn_fence(__ATOMIC_ACQUIRE, "agent");
            if (lane == 0) flag[0] = dead ? 1u : 0u;
        }
        asm volatile("s_waitcnt vmcnt(0) lgkmcnt(0)" ::: "memory"); __builtin_amdgcn_s_barrier(); asm volatile("" ::: "memory");
        const bool bad = flag[0] != 0u;
        if (lane < 32) {
            const unsigned long long* slot = (const unsigned long long*)xbuf + (size_t)(u.pm * BM + row) * 4; float mt[4], m2[4]; float ms = 0.f;
#pragma unroll
            for (int t = 0; t < 4; ++t) { if (t < ntn) { const unsigned long long w = __hip_atomic_load(slot + t, __ATOMIC_RELAXED, __HIP_MEMORY_SCOPE_AGENT); mt[t] = __uint_as_float((unsigned)w); m2[t] = __uint_as_float((unsigned)(w >> 32)); } else { mt[t] = 0.f; m2[t] = 0.f; } ms += mt[t]; }
            const float mean = ms / (float)ntn; float q = 0.f;
#pragma unroll
            for (int t = 0; t < 4; ++t) if (t < ntn) { const float dm = mt[t] - mean; q += m2[t] + 256.0f * dm * dm; }
            S[row] = (f32x2v){mean, 1.0f / sqrtf(q / (256.0f * (float)ntn) + eps)};
        }
        asm volatile("s_waitcnt lgkmcnt(0)" ::: "memory"); __builtin_amdgcn_s_barrier(); asm volatile("" ::: "memory");
        return bad;
    }
};
struct EpiLnRes {
    static constexpr bool PERM = false, AFTER_DRAIN = true;
    const float* base; float* out; int ldc; const float* bias; PanelStats st; unsigned poison;
    __device__ __forceinline__ void fused(f32x4 (&acc)[2][2][4][2], const Unit& u, int wr, int wc, int fr, int fq, PG8_LAS unsigned char* lds, int wid, int lane) const {
        typedef float f32x2v __attribute__((ext_vector_type(2)));
        const PG8_LAS f32x2v* S = (const PG8_LAS f32x2v*)(lds + 8192);
        const int col0 = u.pn * BM + wc * 32 + 4 * fq;
#pragma unroll
        for (int bj = 0; bj < 2; ++bj)
#pragma unroll
            for (int n = 0; n < 2; ++n) { const f32x4 bv = bias ? *(const f32x4*)(bias + col0 + bj * HALF + n * 16) : (f32x4){0.f, 0.f, 0.f, 0.f};
#pragma unroll
                for (int ai = 0; ai < 2; ++ai)
#pragma unroll
                    for (int m = 0; m < 4; ++m) acc[ai][bj][m][n] += bv; }
        f32x4 pre[4][2][2];
#pragma unroll
        for (int m = 0; m < 4; ++m) { const size_t off = (size_t)(u.pm * BM + wr * 64 + m * 16 + fr) * ldc + col0;
#pragma unroll
            for (int bj = 0; bj < 2; ++bj)
#pragma unroll
                for (int n = 0; n < 2; ++n) pre[m][bj][n] = *(const f32x4*)(base + off + bj * HALF + n * 16); }
        const bool bad = st.run(acc, u, wr, wc, fr, fq, lds, wid, lane) || poison != 0u;
        const float qnan = __builtin_nanf("");
#pragma unroll
        for (int ai = 0; ai < 2; ++ai)
#pragma unroll
            for (int m = 0; m < 4; ++m) { const int r = ai * HALF + wr * 64 + m * 16 + fr; const f32x2v sr = S[r]; const size_t off = (size_t)(u.pm * BM + r) * ldc + col0;
#pragma unroll
                for (int bj = 0; bj < 2; ++bj)
#pragma unroll
                    for (int n = 0; n < 2; ++n) { const f32x4 bs = ai == 0 ? pre[m][bj][n] : *(const f32x4*)(base + off + bj * HALF + n * 16); f32x4 o = bs + (acc[ai][bj][m][n] - sr.x) * sr.y;
                        if (bad) o = (f32x4){qnan, qnan, qnan, qnan}; *(f32x4*)(out + off + bj * HALF + n * 16) = o; }
                if (m & 1) asm volatile("" ::: "memory"); }
    }
};
struct EpiLnResLn {
    static constexpr bool PERM = false, AFTER_DRAIN = true;
    const float* base; float* out; bf16_t* xn; int ldc; const float* bias; PanelStats st1, st2; unsigned poison;
    __device__ __forceinline__ void fused(f32x4 (&acc)[2][2][4][2], const Unit& u, int wr, int wc, int fr, int fq, PG8_LAS unsigned char* lds, int wid, int lane) const {
        typedef float f32x2v __attribute__((ext_vector_type(2))); typedef unsigned u32x2v __attribute__((ext_vector_type(2)));
        const PG8_LAS f32x2v* S = (const PG8_LAS f32x2v*)(lds + 8192);
        const int col0 = u.pn * BM + wc * 32 + 4 * fq;
#pragma unroll
        for (int bj = 0; bj < 2; ++bj)
#pragma unroll
            for (int n = 0; n < 2; ++n) { const f32x4 bv = bias ? *(const f32x4*)(bias + col0 + bj * HALF + n * 16) : (f32x4){0.f, 0.f, 0.f, 0.f};
#pragma unroll
                for (int ai = 0; ai < 2; ++ai)
#pragma unroll
                    for (int m = 0; m < 4; ++m) acc[ai][bj][m][n] += bv; }
        bool bad = st1.run(acc, u, wr, wc, fr, fq, lds, wid, lane) || poison != 0u;
        const float qnan = __builtin_nanf("");
#pragma unroll
        for (int ai = 0; ai < 2; ++ai)
#pragma unroll
            for (int m = 0; m < 4; ++m) { const int r = ai * HALF + wr * 64 + m * 16 + fr; const f32x2v sr = S[r]; const size_t off = (size_t)(u.pm * BM + r) * ldc + col0;
#pragma unroll
                for (int bj = 0; bj < 2; ++bj)
#pragma unroll
                    for (int n = 0; n < 2; ++n) { const f32x4 bs = *(const f32x4*)(base + off + bj * HALF + n * 16); acc[ai][bj][m][n] = bs + (acc[ai][bj][m][n] - sr.x) * sr.y; }
                asm volatile("" : "+v"(acc[ai][0][m][0]), "+v"(acc[ai][0][m][1]), "+v"(acc[ai][1][m][0]), "+v"(acc[ai][1][m][1]));
                if (m & 1) asm volatile("" ::: "memory"); }
        const bool bad1 = bad;
        bad = st2.run(acc, u, wr, wc, fr, fq, lds, wid, lane) || bad;
#pragma unroll
        for (int ai = 0; ai < 2; ++ai)
#pragma unroll
            for (int m = 0; m < 4; ++m) { const int r = ai * HALF + wr * 64 + m * 16 + fr; const f32x2v sr = S[r]; const size_t off = (size_t)(u.pm * BM + r) * ldc + col0;
#pragma unroll
                for (int bj = 0; bj < 2; ++bj)
#pragma unroll
                    for (int n = 0; n < 2; ++n) { const f32x4 x1 = acc[ai][bj][m][n]; *(f32x4*)(out + off + bj * HALF + n * 16) = bad1 ? (f32x4){qnan, qnan, qnan, qnan} : x1;
                        const f32x4 o = (x1 - sr.x) * sr.y; u32x2v w; w.x = cvt_pk_bf16(o[0], o[1]); w.y = cvt_pk_bf16(o[2], o[3]);
                        if (bad) { w.x = 0x7fc07fc0u; w.y = 0x7fc07fc0u; } *(u32x2v*)(xn + off + bj * HALF + n * 16) = w; }
                asm volatile("" ::: "memory"); }
    }
};


struct EpiRes {
    static constexpr bool PERM = false, AFTER_DRAIN = false;
    const float* xp; const float* xs; float* out; const float* gate; float alpha;
    __device__ __forceinline__ void operator()(const f32x4 (&acc)[2][2][4][2], const Unit& u, int wr, int wc, int fr, int fq) const {
        const int row0 = u.pm * BM + wr * 64 + fr, col0 = u.pn * BM + wc * 32 + 4 * fq; const bool samp = u.pm >= 64;
#pragma unroll
        for (int ai = 0; ai < 2; ++ai)
#pragma unroll
            for (int m = 0; m < 4; ++m) { const int r = row0 + ai * HALF + m * 16;
                const float* xrow = samp ? xs + (size_t)(r - 16384) * 1024 : xp + (size_t)r * 1024;
                const int mr = samp ? 8 + ((r - 16384) >> 3) : (r >> 11);
                const float* grow = gate + (size_t)mr * 12288; float* orow = out + (size_t)r * 1024;
#pragma unroll
                for (int bj = 0; bj < 2; ++bj)
#pragma unroll
                    for (int n = 0; n < 2; ++n) { const int c = col0 + bj * HALF + n * 16; const f32x4 xv = *(const f32x4*)(xrow + c), gv = *(const f32x4*)(grow + c);
                        *(f32x4*)(orow + c) = xv * alpha + gv * acc[ai][bj][m][n]; }
                asm volatile("" ::: "memory"); }
    }
};
template <class Epi, class Sched, bool ALIGN_EPI = false, bool SP2 = false>
__device__ __forceinline__ void gemm_phase(PG8_LAS unsigned char* lds, const Gemm g, const Sched& S, const Epi& E) {
    int tid_ = threadIdx.x; asm volatile("" : "+v"(tid_));
    const int tid = tid_, wid = __builtin_amdgcn_readfirstlane(tid >> 6), lane = tid & 63, wr = wid >> 2, wc = wid & 3, fr = lane & 15, fq = lane >> 4;
    const int K = g.K, nt = K / BK;
    unsigned voffA[2], voffB[2];
#pragma unroll
    for (int i = 0; i < 2; ++i) { int R, C; stage_rc(tid * 16 + i * 8192, R, C); const int Rb = Epi::PERM ? ((R & ~31) + perm32(R & 31)) : R;
        voffA[i] = (unsigned)(R * K + C) * 2u; voffB[i] = (unsigned)(Rb * K + C) * 2u; }
    const size_t kstep = (size_t)(BK * 2);
    const size_t hstep = (size_t)HALF * K * 2;
    const size_t tstep = 2 * hstep;
    const unsigned ldsw = (unsigned)wid * 1024u;
    const int aoff = lds_byte(wr * 64 + fr, fq * 8), boff = lds_byte(wc * 32 + fr, fq * 8);
#define PG8_SA(b, h) (((b) * 2 + (h)) * HTB)
#define PG8_SB(b, h) ((4 + (b) * 2 + (h)) * HTB)
#define PG8_STAGE(bufoff, gbase, voff) do { _Pragma("unroll") for (int _i = 0; _i < 2; ++_i) \
        __builtin_amdgcn_global_load_lds((const unsigned*)((const char*)(gbase) + (voff)[_i]), (PG8_LAS unsigned*)(lds + (bufoff) + ldsw + _i * 8192), 16, 0, 0); } while (0)
#define PG8_LDA(dst, b, h) do { _Pragma("unroll") for (int m = 0; m < 4; ++m) _Pragma("unroll") for (int k = 0; k < 2; ++k) dst[m][k] = *(const PG8_LAS bf16x8*)(lds + PG8_SA(b, h) + aoff + m * 2048 + k * 1024); } while (0)
#define PG8_LDB(dst, b, h) do { _Pragma("unroll") for (int n = 0; n < 2; ++n) _Pragma("unroll") for (int k = 0; k < 2; ++k) dst[n][k] = *(const PG8_LAS bf16x8*)(lds + PG8_SB(b, h) + boff + n * 2048 + k * 1024); } while (0)
#define PG8_MMA(ai, bj, At, Bt) do { __builtin_amdgcn_s_setprio(1); _Pragma("unroll") for (int m = 0; m < 4; ++m) _Pragma("unroll") for (int n = 0; n < 2; ++n) _Pragma("unroll") for (int k = 0; k < 2; ++k) \
        acc[ai][bj][m][n] = __builtin_amdgcn_mfma_f32_16x16x32_bf16(Bt[n][k], At[m][k], acc[ai][bj][m][n], 0, 0, 0); __builtin_amdgcn_s_setprio(0); } while (0)
#define PG8_WAIT_V(n) asm volatile("s_waitcnt vmcnt(" #n ")" ::: "memory")
#define PG8_WAIT_L(n) asm volatile("s_waitcnt lgkmcnt(" #n ")" ::: "memory")
#define PG8_BAR __builtin_amdgcn_s_barrier()
#define PG8_SCHED __builtin_amdgcn_sched_barrier(0)
    Unit cur, nxt; int ui = 0;
    if (!S.next(0, cur)) return;
    f32x4 acc[2][2][4][2];
#pragma unroll
    for (int a = 0; a < 2; ++a)
#pragma unroll
        for (int b = 0; b < 2; ++b)
#pragma unroll
            for (int m = 0; m < 4; ++m)
#pragma unroll
                for (int n = 0; n < 2; ++n) acc[a][b][m][n] = (f32x4){0.f, 0.f, 0.f, 0.f};
    bf16x8 At[4][2], B0[2][2], B1[2][2];
    const char* cA = (const char*)g.A + (size_t)cur.pm * tstep; const char* cB = (const char*)g.Bt + (size_t)cur.pn * tstep;
    S.a_ready(cur);
    if constexpr (SP2) {
        PG8_STAGE(PG8_SB(0, 0), cB, voffB); PG8_STAGE(PG8_SB(0, 1), cB + hstep, voffB); PG8_STAGE(PG8_SA(0, 0), cA, voffA); PG8_STAGE(PG8_SA(0, 1), cA + hstep, voffA);
        if (wr == 1) PG8_BAR;
        PG8_WAIT_V(2); PG8_BAR;
        PG8_STAGE(PG8_SB(1, 0), cB + kstep, voffB); PG8_STAGE(PG8_SA(1, 0), cA + kstep, voffA); PG8_STAGE(PG8_SB(1, 1), cB + hstep + kstep, voffB);
        PG8_WAIT_V(6); PG8_BAR;
    } else {
        PG8_STAGE(PG8_SB(0, 0), cB, voffB); PG8_STAGE(PG8_SA(0, 0), cA, voffA); PG8_STAGE(PG8_SB(0, 1), cB + hstep, voffB); PG8_STAGE(PG8_SA(0, 1), cA + hstep, voffA);
        if (wr == 1) PG8_BAR;
        PG8_WAIT_V(4); PG8_BAR;
        PG8_STAGE(PG8_SB(1, 0), cB + kstep, voffB); PG8_STAGE(PG8_SA(1, 0), cA + kstep, voffA); PG8_STAGE(PG8_SB(1, 1), cB + hstep + kstep, voffB);
        PG8_WAIT_V(6); PG8_BAR;
    }
    for (;;) {
        const bool has_next = S.next(ui + 1, nxt);
        const char* nA = has_next ? (const char*)g.A + (size_t)nxt.pm * tstep : cA; const char* nB = has_next ? (const char*)g.Bt + (size_t)nxt.pn * tstep : cB;
        for (int t = 0; t < nt; t += 2) {
            const bool last = (t == nt - 2);
            const char* a1 = cA + (size_t)(t + 1) * kstep;
            const char* a2 = last ? nA : cA + (size_t)(t + 2) * kstep; const char* b2 = last ? nB : cB + (size_t)(t + 2) * kstep;
            const char* a3 = a2 + kstep; const char* b3 = b2 + kstep;
            if (last && has_next) S.a_ready(nxt);
            if constexpr (SP2) {
            PG8_LDB(B0, 0, 0); PG8_LDB(B1, 0, 1); PG8_SCHED; PG8_LDA(At, 0, 0); PG8_STAGE(PG8_SA(1, 1), a1 + hstep, voffA);
            PG8_WAIT_V(8); PG8_WAIT_L(0); PG8_BAR; PG8_MMA(0, 0, At, B0); PG8_MMA(0, 1, At, B1); PG8_BAR; PG8_SCHED;
            PG8_LDA(At, 0, 1); PG8_STAGE(PG8_SB(0, 0), b2, voffB); PG8_STAGE(PG8_SB(0, 1), b2 + hstep, voffB); PG8_STAGE(PG8_SA(0, 0), a2, voffA);
            PG8_WAIT_V(8); PG8_WAIT_L(0); PG8_BAR; PG8_MMA(1, 0, At, B0); PG8_MMA(1, 1, At, B1); PG8_BAR; PG8_SCHED;
            PG8_LDB(B0, 1, 0); PG8_LDB(B1, 1, 1); PG8_SCHED; PG8_LDA(At, 1, 0); PG8_STAGE(PG8_SA(0, 1), a2 + hstep, voffA);
            PG8_WAIT_V(8); PG8_WAIT_L(0); PG8_BAR; PG8_MMA(0, 0, At, B0); PG8_MMA(0, 1, At, B1); PG8_BAR; PG8_SCHED;
            PG8_LDA(At, 1, 1); PG8_STAGE(PG8_SB(1, 0), b3, voffB); PG8_STAGE(PG8_SB(1, 1), b3 + hstep, voffB); PG8_STAGE(PG8_SA(1, 0), a3, voffA);
            PG8_WAIT_V(8); PG8_WAIT_L(0); PG8_BAR; PG8_MMA(1, 0, At, B0); PG8_MMA(1, 1, At, B1); PG8_BAR; PG8_SCHED;
            } else {
            PG8_LDB(B0, 0, 0); PG8_SCHED; PG8_LDA(At, 0, 0); PG8_STAGE(PG8_SA(1, 1), a1 + hstep, voffA);
            PG8_WAIT_L(8); PG8_BAR; PG8_WAIT_L(0); PG8_MMA(0, 0, At, B0); PG8_BAR; PG8_SCHED;
            PG8_LDB(B1, 0, 1); PG8_STAGE(PG8_SB(0, 0), b2, voffB);
            PG8_BAR; PG8_WAIT_L(0); PG8_MMA(0, 1, At, B1); PG8_BAR;
            PG8_LDA(At, 0, 1); PG8_STAGE(PG8_SA(0, 0), a2, voffA);
            PG8_BAR; PG8_WAIT_L(0); PG8_MMA(1, 0, At, B0); PG8_BAR; PG8_SCHED;
            PG8_STAGE(PG8_SB(0, 1), b2 + hstep, voffB);
            PG8_WAIT_V(6); PG8_BAR; PG8_MMA(1, 1, At, B1); PG8_BAR;
            PG8_LDB(B0, 1, 0); PG8_SCHED; PG8_LDA(At, 1, 0); PG8_STAGE(PG8_SA(0, 1), a2 + hstep, voffA);
            PG8_WAIT_L(8); PG8_BAR; PG8_WAIT_L(0); PG8_MMA(0, 0, At, B0); PG8_BAR; PG8_SCHED;
            PG8_LDB(B1, 1, 1); PG8_STAGE(PG8_SB(1, 0), b3, voffB);
            PG8_BAR; PG8_WAIT_L(0); PG8_MMA(0, 1, At, B1); PG8_BAR;
            PG8_LDA(At, 1, 1); PG8_STAGE(PG8_SA(1, 0), a3, voffA);
            PG8_BAR; PG8_WAIT_L(0); PG8_MMA(1, 0, At, B0); PG8_BAR; PG8_SCHED;
            PG8_STAGE(PG8_SB(1, 1), b3 + hstep, voffB);
            PG8_WAIT_V(6); PG8_BAR; PG8_MMA(1, 1, At, B1); PG8_BAR;
            }
        }
        if constexpr (ALIGN_EPI) { if (wr == 0) PG8_BAR; }
        if constexpr (!Epi::AFTER_DRAIN) { E(acc, cur, wr, wc, fr, fq); S.done(cur); }
        if (!has_next) break;
#pragma unroll
        for (int a = 0; a < 2; ++a)
#pragma unroll
            for (int b = 0; b < 2; ++b)
#pragma unroll
                for (int m = 0; m < 4; ++m)
#pragma unroll
                    for (int n = 0; n < 2; ++n) acc[a][b][m][n] = (f32x4){0.f, 0.f, 0.f, 0.f};
        cur = nxt; cA = nA; cB = nB; ++ui;
        if constexpr (ALIGN_EPI) { if (wr == 1) PG8_BAR; }
    }
    PG8_WAIT_V(0);
    if constexpr (!ALIGN_EPI) { if (wr == 0) PG8_BAR; }
    PG8_BAR;
    if constexpr (Epi::AFTER_DRAIN) { E.fused(acc, cur, wr, wc, fr, fq, lds, wid, lane); S.done(cur); }
#undef PG8_SA
#undef PG8_SB
#undef PG8_STAGE
#undef PG8_LDA
#undef PG8_LDB
#undef PG8_MMA
#undef PG8_WAIT_V
#undef PG8_WAIT_L
#undef PG8_BAR
#undef PG8_SCHED
}
}


constexpr int NWAVES = 8;
constexpr int D = 1024, BP = 8, TP = 2048, BS = 128, TS = 8, MP = BP * TP, MS = BS * TS, M = MP + MS, NIN = 2048, FF = 4096, NL = 2;
constexpr int NMODROW = 256, NMOD = 6144, MODLD = NL * NMOD;
constexpr float LN_EPS = 1e-5f;
constexpr float DN_ALPHA = 1.41421356237309515f;
constexpr size_t O_YP = 0, O_YS = (size_t)MP * D, O_CP = O_YS + (size_t)MS * D, O_PP = O_CP + (size_t)NL * BP * 2 * 256, O_CS = O_PP + (size_t)NL * BP * 15 * 256,
                 O_PS = O_CS + (size_t)NL * BS * 2 * 256, O_VS = O_PS + (size_t)NL * BS * 15 * 256, O_END = O_VS + (size_t)NL * BS * TS * 512;
constexpr size_t MiB = 1u << 20;
constexpr size_t WS_CTL = 0, CTL_ZERO_BYTES = 1 * MiB;
constexpr size_t WS_WIN = 2 * MiB, WS_WOUT = 10 * MiB, WS_WUP = 14 * MiB, WS_WDN = 30 * MiB;
constexpr size_t WS_MOD = 46 * MiB, WS_X = 58 * MiB, WS_HA = 60 * MiB, WS_BIG = 94 * MiB;
constexpr size_t WS_PROJ = WS_BIG, WS_MIX = WS_BIG + 68 * MiB, WS_HID = WS_BIG;
constexpr size_t WS_WADA = WS_BIG, WS_AC = WS_BIG + 24 * MiB;
constexpr size_t WS_END = WS_BIG + 136 * MiB;
static_assert(WS_END <= 256 * MiB, "d_ws map");
constexpr size_t WS_WTRIL = WS_X, WS_PWT = WS_X + 512 * 1024;
constexpr int CW_TMO = 0, CW_CODE = 1, CW_BAR = 4096;

constexpr int LDSCTL_OFF = 0, LDSCTL_BYTES = 512, MISC_OFF = LDSCTL_OFF + 320, RING_OFF = 512, RING_BYTES = 131072;
constexpr int VN_RS = 544, DT_RS = 528, MIX_LDS = 128 * VN_RS + 128 * DT_RS;
constexpr int LDS_BYTES = RING_OFF + (MIX_LDS > RING_BYTES ? MIX_LDS : RING_BYTES) + 512;
static_assert(LDS_BYTES <= 160 * 1024 && LDS_BYTES > 80 * 1024 && RING_OFF % 16 == 0, "LDS map");

#define GAS __attribute__((address_space(1)))
#define LAS __attribute__((address_space(3)))
typedef unsigned short bf16;
typedef unsigned v4u __attribute__((ext_vector_type(4)));
typedef unsigned v2u __attribute__((ext_vector_type(2)));
typedef float f32x4 __attribute__((ext_vector_type(4)));
typedef GAS unsigned gu32;
#define RLX_AGENT __ATOMIC_RELAXED, __HIP_MEMORY_SCOPE_AGENT
#define LDS_WAIT() asm volatile("s_waitcnt lgkmcnt(0)" ::: "memory")
#define VM_WAIT() asm volatile("s_waitcnt vmcnt(0)" ::: "memory")
__device__ __forceinline__ unsigned f2bf(float f) { unsigned u = __builtin_bit_cast(unsigned, f); return (u + 0x7fffu + ((u >> 16) & 1u)) >> 16; }
__device__ __forceinline__ unsigned pk2(float lo, float hi) { return f2bf(lo) | (f2bf(hi) << 16); }
__device__ __forceinline__ float bflo(unsigned w) { return __builtin_bit_cast(float, w << 16); }
__device__ __forceinline__ float bfhi(unsigned w) { return __builtin_bit_cast(float, w & 0xffff0000u); }
__device__ __forceinline__ float bf1(bf16 h) { return __builtin_bit_cast(float, (unsigned)h << 16); }

#define XB_TMO      128
#define XB_XCNT(j)  (256  + 64 * (j))
#define XB_XSUB(j)  (1280 + 64 * (j))
#define XB_XGEN(j)  (2304 + 64 * (j))
#define XB_TOP      3328
#define XB_TOPGEN   3392
#define XCD_BAR_WORDS 3456
#define XB_SPIN_CAP (1u << 18)

__device__ __forceinline__ unsigned xb_ld(unsigned* p)              { return __hip_atomic_load(p, __ATOMIC_RELAXED, __HIP_MEMORY_SCOPE_AGENT); }
__device__ __forceinline__ unsigned xb_add(unsigned* p, unsigned v) { return __hip_atomic_fetch_add(p, v, __ATOMIC_RELAXED, __HIP_MEMORY_SCOPE_AGENT); }
__device__ __forceinline__ unsigned xb_xcc_id() { return (unsigned)__builtin_amdgcn_s_getreg((3 << 11) | 20) & 0xFu; }
#define XB_SPIN(cond, bar) do { unsigned _sp = 0; while (cond) { __builtin_amdgcn_s_sleep(1); \
    if ((++_sp & 255u) == 0u) { if (xb_ld(&(bar)[XB_TMO])) break; if (_sp > XB_SPIN_CAP) { atomicAdd(&(bar)[XB_TMO], 1u); break; } } } } while (0)

struct XcdBarrier {
    unsigned* bar; unsigned x;
    volatile LAS unsigned* st;
};

__device__ __forceinline__ XcdBarrier xcd_barrier_post(unsigned* bar, volatile LAS unsigned* st) {
    XcdBarrier b; b.bar = bar; b.x = xb_xcc_id(); b.st = st;
    if (threadIdx.x == 0) (void)xb_add(&bar[XB_XCNT(b.x)], 1u);
    return b;
}
__device__ __forceinline__ void xcd_barrier_complete(unsigned* bar, unsigned x, unsigned& nloc, unsigned& nx) {
    const unsigned G = gridDim.x * gridDim.y * gridDim.z;
    unsigned sum, cnt, mine, sp = 0u;
    for (;;) {
        sum = 0u; cnt = 0u; mine = 0u;
#pragma unroll
        for (unsigned j = 0; j < 16; ++j) { const unsigned c = xb_ld(&bar[XB_XCNT(j)]); sum += c; cnt += (c > 0u) ? 1u : 0u; mine = (j == x) ? c : mine; }
        if (sum == G) break;
        __builtin_amdgcn_s_sleep(1);
        if ((++sp & 255u) == 0u) { if (xb_ld(&bar[XB_TMO])) break; if (sp > XB_SPIN_CAP) { atomicAdd(&bar[XB_TMO], 1u); break; } }
    }
    nloc = mine > 0u ? mine : 1u; nx = cnt > 0u ? cnt : 1u;
}

__device__ __forceinline__ void xcd_barrier(const XcdBarrier& b) {
    asm volatile("s_waitcnt vmcnt(0)" ::: "memory");
    __syncthreads();
    if (threadIdx.x == 0) {
        unsigned* bar = b.bar;
        __builtin_amdgcn_s_waitcnt(0);
        unsigned nloc = b.st[0], nx = b.st[1];
        if (nloc == 0u) { xcd_barrier_complete(bar, b.x, nloc, nx); b.st[0] = nloc; b.st[1] = nx; }
        const unsigned old = xb_add(&bar[XB_XSUB(b.x)], 1u);
        const unsigned gen = old / nloc;
        if (old + 1u == (gen + 1u) * nloc) {
            __builtin_amdgcn_fence(__ATOMIC_RELEASE, "agent");
            asm volatile("s_waitcnt vmcnt(0)" ::: "memory");
            const unsigned og = xb_add(&bar[XB_TOP], 1u);
            const unsigned tg = og / nx;
            if (og + 1u == (tg + 1u) * nx) xb_add(&bar[XB_TOPGEN], 1u);
            else XB_SPIN(xb_ld(&bar[XB_TOPGEN]) == tg, bar);
            __builtin_amdgcn_fence(__ATOMIC_ACQUIRE, "agent");
            xb_add(&bar[XB_XGEN(b.x)], 1u);
            asm volatile("s_waitcnt vmcnt(0)" ::: "memory");
        } else {
            XB_SPIN(xb_ld(&bar[XB_XGEN(b.x)]) == gen, bar);
            __builtin_amdgcn_fence(__ATOMIC_ACQUIRE, "agent");
            asm volatile("s_waitcnt vmcnt(0)" ::: "memory");
        }
    }
    __syncthreads();
}


struct Args { const float* in[23]; float* out; unsigned char* ws; int ph_lo, ph_hi; };
struct Frame {
    LAS unsigned char* lds; volatile LAS unsigned* MISC; gu32* ctl;
    int tid, lane, wave, vcu, G;
};
__device__ __forceinline__ float wave_sum(float v) {
#pragma unroll
    for (int o = 1; o < 64; o <<= 1) v += __shfl_xor(v, o);
    return v;
}
__device__ __forceinline__ int mod_row(int r) { return r < MP ? (r >> 11) : BP + ((r - MP) >> 3); }

__device__ __forceinline__ void p0_transpose_item(const float* W, int K, int N, bf16* WT, int row_off, LAS float* scr, int item, int lane) {
    const int nblk = N / 32, kb = item / nblk, nb = item % nblk, k0 = 64 * kb, n0 = 32 * nb;
#pragma unroll 8
    for (int i = 0; i < 32; ++i) { const int kk = 2 * i + (lane >> 5); scr[kk * 33 + (lane & 31)] = W[(size_t)(k0 + kk) * N + n0 + (lane & 31)]; }
    LDS_WAIT(); asm volatile("" ::: "memory");
    const int c = lane & 7;
#pragma unroll
    for (int j = 0; j < 4; ++j) { const int n = (lane >> 3) + 8 * j; const LAS float* s = scr + (8 * c) * 33 + n;
        v4u o; o.x = pk2(s[0 * 33], s[1 * 33]); o.y = pk2(s[2 * 33], s[3 * 33]); o.z = pk2(s[4 * 33], s[5 * 33]); o.w = pk2(s[6 * 33], s[7 * 33]);
        *(GAS v4u*)(WT + (size_t)(row_off + n0 + n) * K + k0 + 8 * c) = o; }
    LDS_WAIT(); asm volatile("" ::: "memory");
}

__device__ __forceinline__ void p0_prologue(Frame& F, const Args& a) {
    LAS float* scr = (LAS float*)(F.lds + RING_OFF + F.wave * 16384);
    const int gw = F.vcu * NWAVES + F.wave, NGW = F.G * NWAVES;
    unsigned char* ws = a.ws;
    constexpr int I_IN = (D / 64) * (NIN / 32), I_OUT = (D / 64) * (D / 32), I_UP = (D / 64) * (FF / 32), I_DN = (FF / 64) * (D / 32), I_ADA = (D / 64) * (NMOD / 32);
    constexpr int PER_L = I_IN + I_OUT + I_UP + I_DN + I_ADA, NITEMS = NL * PER_L;
    for (int it = gw; it < NITEMS; it += NGW) {
        const int l = it / PER_L; int r = it % PER_L;
        if (r < I_ADA) { p0_transpose_item(a.in[6] + (size_t)l * D * NMOD, D, NMOD, (bf16*)(ws + WS_WADA), l * NMOD, scr, r, F.lane); continue; } r -= I_ADA;
        if (r < I_IN) { p0_transpose_item(a.in[8] + (size_t)l * D * NIN, D, NIN, (bf16*)(ws + WS_WIN) + (size_t)l * NIN * D, 0, scr, r, F.lane); continue; } r -= I_IN;
        if (r < I_OUT) { p0_transpose_item(a.in[16] + (size_t)l * D * D, D, D, (bf16*)(ws + WS_WOUT) + (size_t)l * D * D, 0, scr, r, F.lane); continue; } r -= I_OUT;
        if (r < I_UP) { p0_transpose_item(a.in[19] + (size_t)l * D * FF, D, FF, (bf16*)(ws + WS_WUP) + (size_t)l * FF * D, 0, scr, r, F.lane); continue; } r -= I_UP;
        p0_transpose_item(a.in[20] + (size_t)l * FF * D, FF, D, (bf16*)(ws + WS_WDN) + (size_t)l * D * FF, 0, scr, r, F.lane);
    }
    {
        const int gt = F.vcu * (NWAVES * 64) + F.tid, NGT = F.G * NWAVES * 64;
        bf16* WT = (bf16*)(ws + WS_WTRIL); bf16* PWT = (bf16*)(ws + WS_PWT);
        for (int e = gt; e < NL * 8 * 128 * 128; e += NGT) { const int j = e & 127, i = (e >> 7) & 127; WT[e] = (bf16)(j <= i ? f2bf(a.in[12][e]) : 0u); }
        for (int e = gt; e < NL * 4 * 64 * 64; e += NGT) { const int c = e & 63, dd = (e >> 6) & 63, lg = e >> 12; PWT[e] = (bf16)f2bf(a.in[14][((size_t)lg * 64 + c) * 64 + dd]); }
    }
    bf16* AC = (bf16*)(ws + WS_AC);
    for (int m = gw; m < NMODROW; m += NGW) {
        GAS unsigned long long* o8 = (GAS unsigned long long*)(AC + (size_t)m * D) + F.lane;
        if (m < BP + BS) { const float* crow = m < BP ? a.in[2] + (size_t)m * D : a.in[3] + (size_t)(m - BP) * D;
            const GAS f32x4* xr = (const GAS f32x4*)crow + F.lane;
#pragma unroll
            for (int j = 0; j < 4; ++j) { f32x4 v = xr[64 * j];
#pragma unroll
                for (int e = 0; e < 4; ++e) v[e] = v[e] / (1.0f + __expf(-v[e]));
                o8[64 * j] = (unsigned long long)pk2(v.x, v.y) | ((unsigned long long)pk2(v.z, v.w) << 32); }
        } else {
#pragma unroll
            for (int j = 0; j < 4; ++j) o8[64 * j] = 0ull; }
    }
}

__device__ __forceinline__ void modulate_rows(Frame& F, const float* xp, const float* xs, const float* mod_sh, const float* mod_sc, bf16* hb) {
    const int gw = F.vcu * NWAVES + F.wave, NGW = F.G * NWAVES;
    for (int r = gw; r < M; r += NGW) {
        const float* xrow = r < MP ? xp + (size_t)r * D : xs + (size_t)(r - MP) * D; const int mr = mod_row(r);
        const GAS f32x4* xr = (const GAS f32x4*)xrow + F.lane; const GAS f32x4* sh = (const GAS f32x4*)(mod_sh + (size_t)mr * MODLD) + F.lane; const GAS f32x4* sc = (const GAS f32x4*)(mod_sc + (size_t)mr * MODLD) + F.lane;
        GAS unsigned long long* o8 = (GAS unsigned long long*)(hb + (size_t)r * D) + F.lane;
#pragma unroll
        for (int j = 0; j < 4; ++j) { const f32x4 v = xr[64 * j], a = sh[64 * j], b = sc[64 * j]; const f32x4 h = v * (b + 1.0f) + a;
            o8[64 * j] = (unsigned long long)pk2(h.x, h.y) | ((unsigned long long)pk2(h.z, h.w) << 32); }
    }
}
__device__ __forceinline__ void ln_rows(Frame& F, float* x, const float* g, const float* b, const float* mod_sh, const float* mod_sc, bf16* hb) {
    const int gw = F.vcu * NWAVES + F.wave, NGW = F.G * NWAVES;
    for (int r = gw; r < M; r += NGW) {
        GAS f32x4* xr = (GAS f32x4*)(x + (size_t)r * D) + F.lane; const int mr = mod_row(r);
        f32x4 v[4]; float s = 0.f;
#pragma unroll
        for (int j = 0; j < 4; ++j) { v[j] = xr[64 * j]; s += (v[j].x + v[j].y) + (v[j].z + v[j].w); }
        const float mean = wave_sum(s) * (1.f / D); float s2 = 0.f;
#pragma unroll
        for (int j = 0; j < 4; ++j) { v[j] = v[j] - mean; s2 += (v[j].x * v[j].x + v[j].y * v[j].y) + (v[j].z * v[j].z + v[j].w * v[j].w); }
        const float rstd = 1.f / sqrtf(wave_sum(s2) * (1.f / D) + LN_EPS);
#pragma unroll
        for (int j = 0; j < 4; ++j) { const f32x4 gg = ((const GAS f32x4*)g)[F.lane + 64 * j], bb = ((const GAS f32x4*)b)[F.lane + 64 * j]; v[j] = v[j] * rstd * gg + bb; xr[64 * j] = v[j]; }
        if (hb) { const GAS f32x4* sh = (const GAS f32x4*)(mod_sh + (size_t)mr * MODLD) + F.lane; const GAS f32x4* sc = (const GAS f32x4*)(mod_sc + (size_t)mr * MODLD) + F.lane;
            GAS unsigned long long* o8 = (GAS unsigned long long*)(hb + (size_t)r * D) + F.lane;
#pragma unroll
            for (int j = 0; j < 4; ++j) { const f32x4 h = v[j] * (sc[64 * j] + 1.0f) + sh[64 * j]; o8[64 * j] = (unsigned long long)pk2(h.x, h.y) | ((unsigned long long)pk2(h.z, h.w) << 32); } }
    }
}

__device__ __forceinline__ void unpack4(v2u w, float (&f)[4]) { f[0] = bflo(w.x); f[1] = bfhi(w.x); f[2] = bflo(w.y); f[3] = bfhi(w.y); }

__device__ __forceinline__ void conv_phase(Frame& F, const Args& a, int l, const bf16* proj, bf16* mix, int tg_lo, int tg_hi) {
    const int gt = F.vcu * (NWAVES * 64) + F.tid, NGT = F.G * NWAVES * 64;
    const float* cw = a.in[9] + (size_t)l * 3 * 256;
    for (int it = gt; it < (tg_hi - tg_lo) * 64; it += NGT) {
        const int cg = it & 63, tg = tg_lo + (it >> 6), r0 = tg * 8, c = cg * 4; const bool samp = r0 >= MP;
        const int t0 = samp ? 0 : (r0 & (TP - 1)); const int sb = samp ? (r0 - MP) >> 3 : (r0 >> 11);
        float zm2[4] = {0.f, 0.f, 0.f, 0.f}, zm1[4] = {0.f, 0.f, 0.f, 0.f};
        if (samp) { const float* st = a.in[4] + ((size_t)(l * BS + sb) * 2) * 256 + c; const f32x4 s0 = *(const f32x4*)st, s1 = *(const f32x4*)(st + 256);
#pragma unroll
            for (int e = 0; e < 4; ++e) { zm2[e] = s0[e]; zm1[e] = s1[e]; } }
        else if (t0 != 0) { float p[4], q[4];
            unpack4(*(const v2u*)(proj + (size_t)(r0 - 2) * NIN + 256 + c), p); unpack4(*(const v2u*)(proj + (size_t)(r0 - 2) * NIN + 512 + c), q);
#pragma unroll
            for (int e = 0; e < 4; ++e) zm2[e] = p[e] * q[e];
            unpack4(*(const v2u*)(proj + (size_t)(r0 - 1) * NIN + 256 + c), p); unpack4(*(const v2u*)(proj + (size_t)(r0 - 1) * NIN + 512 + c), q);
#pragma unroll
            for (int e = 0; e < 4; ++e) zm1[e] = p[e] * q[e]; }
        const f32x4 w0 = *(const f32x4*)(cw + c), w1 = *(const f32x4*)(cw + 256 + c), w2 = *(const f32x4*)(cw + 512 + c);
        const bool last_p = (!samp) && (t0 + 8 == TP);
#pragma unroll
        for (int tt = 0; tt < 8; ++tt) { const size_t ro = (size_t)(r0 + tt) * NIN; float ab[4], ac[4], ax[4], z[4], y[4];
            unpack4(*(const v2u*)(proj + ro + c), ab); unpack4(*(const v2u*)(proj + ro + 256 + c), ac); unpack4(*(const v2u*)(proj + ro + 512 + c), ax);
#pragma unroll
            for (int e = 0; e < 4; ++e) { z[e] = ac[e] * ax[e]; y[e] = ab[e] * (zm2[e] * w0[e] + zm1[e] * w1[e] + z[e] * w2[e]); zm2[e] = zm1[e]; zm1[e] = z[e]; }
            v2u o; o.x = pk2(y[0], y[1]); o.y = pk2(y[2], y[3]); *(v2u*)(mix + (size_t)(r0 + tt) * D + c) = o;
            if (tt >= 6) { const f32x4 zz = {z[0], z[1], z[2], z[3]};
                if (samp) *(f32x4*)(a.out + O_CS + ((size_t)(l * BS + sb) * 2 + (tt - 6)) * 256 + c) = zz;
                else if (last_p) *(f32x4*)(a.out + O_CP + ((size_t)(l * BP + sb) * 2 + (tt - 6)) * 256 + c) = zz; }
        }
    }
}

template <int W> __device__ __forceinline__ void pool_item(Frame& F, const Args& a, int l, const bf16* proj, bf16* mix, int tg, int g) {
    const int lane = F.lane, ch = g * 64 + lane, r0 = tg * 8; const bool samp = r0 >= MP;
    const int t0 = samp ? 0 : (r0 & (TP - 1)); const int sb = samp ? (r0 - MP) >> 3 : (r0 >> 11);
    float e[W - 1 + 8];
#pragma unroll
    for (int k = -(W - 1); k < 8; ++k) { float v;
        if (k >= 0) v = bf1(proj[(size_t)(r0 + k) * NIN + 1792 + ch]);
        else if (samp) v = a.in[5][((size_t)(l * BS + sb) * 15 + (15 + k)) * 256 + ch];
        else v = (t0 + k >= 0) ? bf1(proj[(size_t)(r0 + k) * NIN + 1792 + ch]) : 0.f;
        e[k + W - 1] = v; }
    float d[8];
#pragma unroll
    for (int tt = 0; tt < 8; ++tt) { float s = 0.f;
#pragma unroll
        for (int i = 0; i < W; ++i) s += e[tt - i + W - 1];
        const int cnt = samp ? W : ((t0 + tt + 1) < W ? (t0 + tt + 1) : W);
        d[tt] = s / (float)cnt - e[tt + W - 1]; }
    float acc[8] = {0.f, 0.f, 0.f, 0.f, 0.f, 0.f, 0.f, 0.f};
    const float* pw = a.in[14] + ((size_t)(l * 4 + g) * 64) * 64 + lane;
    for (int c = 0; c < 64; ++c) { const float w = pw[(size_t)c * 64];
#pragma unroll
        for (int tt = 0; tt < 8; ++tt) acc[tt] += __builtin_bit_cast(float, __builtin_amdgcn_readlane(__builtin_bit_cast(int, d[tt]), c)) * w; }
    const float ps = a.in[15][l * 256 + ch];
#pragma unroll
    for (int tt = 0; tt < 8; ++tt) mix[(size_t)(r0 + tt) * D + 768 + ch] = (bf16)f2bf(acc[tt] * ps);
    if (samp) { float* o = a.out + O_PS + ((size_t)(l * BS + sb) * 15) * 256 + ch;
#pragma unroll
        for (int j = 0; j < 7; ++j) o[(size_t)j * 256] = a.in[5][((size_t)(l * BS + sb) * 15 + (8 + j)) * 256 + ch];
#pragma unroll
        for (int j = 7; j < 15; ++j) o[(size_t)j * 256] = e[(j - 7) + W - 1];
    } else if (t0 + 8 > TP - 15) { float* o = a.out + O_PP + ((size_t)(l * BP + sb) * 15) * 256 + ch;
#pragma unroll
        for (int tt = 0; tt < 8; ++tt) { const int j = t0 + tt - (TP - 15); if (j >= 0) o[(size_t)j * 256] = e[tt + W - 1]; } }
}
__device__ __forceinline__ void pool_phase(Frame& F, const Args& a, int l, const bf16* proj, bf16* mix, int tg_lo, int tg_hi) {
    const int gw = F.vcu * NWAVES + F.wave, NGW = F.G * NWAVES;
    for (int it = gw; it < (tg_hi - tg_lo) * 4; it += NGW) { const int g = it & 3, tg = tg_lo + (it >> 2);
        if (g == 0) pool_item<2>(F, a, l, proj, mix, tg, 0); else if (g == 1) pool_item<4>(F, a, l, proj, mix, tg, 1);
        else if (g == 2) pool_item<8>(F, a, l, proj, mix, tg, 2); else pool_item<16>(F, a, l, proj, mix, tg, 3); }
}

__device__ __forceinline__ void sgu_phase(Frame& F, const Args& a, int l, const bf16* proj, bf16* mix) {
    LAS float* VN = (LAS float*)(F.lds + RING_OFF);
    const float* sg = a.in[10] + l * 512; const float* sbv = a.in[11] + l * 512;
    for (int unit = F.vcu; unit < (M / 128) * 2; unit += F.G) {
        const int hh = unit & 1, ck = unit >> 1, r0 = ck * 128; const bool samp = r0 >= MP;
        for (int i = F.wave * 16; i < F.wave * 16 + 16; ++i) { const int r = r0 + i;
            const v4u raw = *(const v4u*)(proj + (size_t)r * NIN + 1280 + 8 * F.lane);
            float v[8] = {bflo(raw.x), bfhi(raw.x), bflo(raw.y), bfhi(raw.y), bflo(raw.z), bfhi(raw.z), bflo(raw.w), bfhi(raw.w)}; float s = 0.f;
#pragma unroll
            for (int k = 0; k < 8; ++k) s += v[k];
            const float mean = wave_sum(s) * (1.f / 512.f); float s2 = 0.f;
#pragma unroll
            for (int k = 0; k < 8; ++k) { v[k] -= mean; s2 += v[k] * v[k]; }
            const float rstd = 1.f / sqrtf(wave_sum(s2) * (1.f / 512.f) + LN_EPS);
            if ((F.lane >> 5) == hh) { const f32x4 g0 = *(const f32x4*)(sg + 8 * F.lane), g1 = *(const f32x4*)(sg + 8 * F.lane + 4), b0 = *(const f32x4*)(sbv + 8 * F.lane), b1 = *(const f32x4*)(sbv + 8 * F.lane + 4);
                f32x4 o0 = {v[0], v[1], v[2], v[3]}, o1 = {v[4], v[5], v[6], v[7]}; o0 = o0 * rstd * g0 + b0; o1 = o1 * rstd * g1 + b1;
                LAS f32x4* dst = (LAS f32x4*)(VN + i * 256 + 8 * (F.lane & 31)); dst[0] = o0; dst[1] = o1;
                if (samp) { float* vo = a.out + O_VS + ((size_t)l * MS + (r - MP)) * 512 + 8 * F.lane; *(f32x4*)vo = o0; *(f32x4*)(vo + 4) = o1; } }
        }
        LDS_WAIT(); __syncthreads();
        for (int p = F.wave; p < 4 * 128; p += NWAVES) { const int hl = p & 3, i = p >> 2, h = hh * 4 + hl, j0 = samp ? (i & ~7) : 0;
            const float* wrow = a.in[12] + ((size_t)(l * 8 + h) * 128 + (i - j0)) * 128; float acc = 0.f;
            for (int j = j0; j <= i; ++j) acc += wrow[j - j0] * VN[j * 256 + hl * 64 + F.lane];
            const float s = acc + a.in[13][(l * 8 + h) * 128 + (i - j0)];
            const float u = bf1(proj[(size_t)(r0 + i) * NIN + 768 + h * 64 + F.lane]);
            mix[(size_t)(r0 + i) * D + 256 + h * 64 + F.lane] = (bf16)f2bf(u * s); }
        LDS_WAIT(); __syncthreads();
    }
}

typedef short bf16x8 __attribute__((ext_vector_type(8)));
typedef short s16x4 __attribute__((ext_vector_type(4)));
__device__ __forceinline__ s16x4 vtr(const LAS unsigned char* p) { return __builtin_bit_cast(s16x4, __builtin_amdgcn_ds_read_tr16_b64_v4i16((LAS s16x4*)p)); }

__device__ __forceinline__ void sgu_sample_item(Frame& F, const Args& a, int l, const bf16* proj, bf16* mix, int b) {
    const int lane = F.lane, h = lane >> 3; const size_t rb = (size_t)MP + 8 * b;
    const f32x4 g0 = *(const f32x4*)(a.in[10] + l * 512 + 8 * lane), g1 = *(const f32x4*)(a.in[10] + l * 512 + 8 * lane + 4), b0 = *(const f32x4*)(a.in[11] + l * 512 + 8 * lane), b1 = *(const f32x4*)(a.in[11] + l * 512 + 8 * lane + 4);
    float vn[8][8];
#pragma unroll
    for (int t = 0; t < 8; ++t) { const v4u raw = *(const v4u*)(proj + (rb + t) * NIN + 1280 + 8 * lane);
        float v[8] = {bflo(raw.x), bfhi(raw.x), bflo(raw.y), bfhi(raw.y), bflo(raw.z), bfhi(raw.z), bflo(raw.w), bfhi(raw.w)}; float s = 0.f;
#pragma unroll
        for (int k = 0; k < 8; ++k) s += v[k];
        const float mean = wave_sum(s) * (1.f / 512.f); float s2 = 0.f;
#pragma unroll
        for (int k = 0; k < 8; ++k) { v[k] -= mean; s2 += v[k] * v[k]; }
        const float rstd = 1.f / sqrtf(wave_sum(s2) * (1.f / 512.f) + LN_EPS);
        f32x4 o0 = {v[0], v[1], v[2], v[3]}, o1 = {v[4], v[5], v[6], v[7]}; o0 = o0 * rstd * g0 + b0; o1 = o1 * rstd * g1 + b1;
        float* vo = a.out + O_VS + ((size_t)l * MS + 8 * b + t) * 512 + 8 * lane; *(f32x4*)vo = o0; *(f32x4*)(vo + 4) = o1;
#pragma unroll
        for (int k = 0; k < 4; ++k) { vn[t][k] = o0[k]; vn[t][4 + k] = o1[k]; } }
    const float* wh = a.in[12] + (size_t)(l * 8 + h) * 128 * 128; const float* bh = a.in[13] + (l * 8 + h) * 128;
#pragma unroll
    for (int i = 0; i < 8; ++i) { float s[8]; const float bs = bh[i];
#pragma unroll
        for (int k = 0; k < 8; ++k) s[k] = bs;
#pragma unroll
        for (int j = 0; j <= i; ++j) { const float w = wh[i * 128 + j];
#pragma unroll
            for (int k = 0; k < 8; ++k) s[k] += w * vn[j][k]; }
        const v4u uw = *(const v4u*)(proj + (rb + i) * NIN + 768 + 8 * lane);
        v4u o; o.x = pk2(bflo(uw.x) * s[0], bfhi(uw.x) * s[1]); o.y = pk2(bflo(uw.y) * s[2], bfhi(uw.y) * s[3]); o.z = pk2(bflo(uw.z) * s[4], bfhi(uw.z) * s[5]); o.w = pk2(bflo(uw.w) * s[6], bfhi(uw.w) * s[7]);
        *(v4u*)(mix + (rb + i) * D + 256 + 8 * lane) = o; }
}

__device__ __forceinline__ void mixer_prompt_unit(Frame& F, const Args& a, int l, const bf16* proj, bf16* mix, const bf16* WT, const bf16* PWT, int unit) {
    const int hh = unit & 1, ck = unit >> 1, r0 = ck * 128, t0 = r0 & (TP - 1), bb = r0 >> 11, lane = F.lane, w = F.wave, tid = F.tid;
    LAS unsigned char* VN = F.lds + RING_OFF; LAS unsigned char* DT = VN + 128 * VN_RS;
    {
        const f32x4 g0 = *(const f32x4*)(a.in[10] + l * 512 + 8 * lane), g1 = *(const f32x4*)(a.in[10] + l * 512 + 8 * lane + 4), b0 = *(const f32x4*)(a.in[11] + l * 512 + 8 * lane), b1 = *(const f32x4*)(a.in[11] + l * 512 + 8 * lane + 4);
        v4u raw[16];
#pragma unroll
        for (int i = 0; i < 16; ++i) raw[i] = *(const v4u*)(proj + (size_t)(r0 + w * 16 + i) * NIN + 1280 + 8 * lane);
#pragma unroll
        for (int i = 0; i < 16; ++i) {
            float v[8] = {bflo(raw[i].x), bfhi(raw[i].x), bflo(raw[i].y), bfhi(raw[i].y), bflo(raw[i].z), bfhi(raw[i].z), bflo(raw[i].w), bfhi(raw[i].w)}; float s = 0.f;
#pragma unroll
            for (int k = 0; k < 8; ++k) s += v[k];
            const float mean = wave_sum(s) * (1.f / 512.f); float s2 = 0.f;
#pragma unroll
            for (int k = 0; k < 8; ++k) { v[k] -= mean; s2 += v[k] * v[k]; }
            const float rstd = 1.f / sqrtf(wave_sum(s2) * (1.f / 512.f) + LN_EPS);
            if ((lane >> 5) == hh) { f32x4 o0 = {v[0], v[1], v[2], v[3]}, o1 = {v[4], v[5], v[6], v[7]}; o0 = o0 * rstd * g0 + b0; o1 = o1 * rstd * g1 + b1;
                v4u o; o.x = pk2(o0[0], o0[1]); o.y = pk2(o0[2], o0[3]); o.z = pk2(o1[0], o1[1]); o.w = pk2(o1[2], o1[3]);
                *(LAS v4u*)(VN + (w * 16 + i) * VN_RS + 16 * (lane & 31)) = o; }
        }
    }
    const int cg = tid & 63, c = 4 * cg;
    if (hh == 0) {
        const float* cw = a.in[9] + (size_t)l * 3 * 256;
        const f32x4 w0 = *(const f32x4*)(cw + c), w1 = *(const f32x4*)(cw + 256 + c), w2 = *(const f32x4*)(cw + 512 + c);
        const int rs = r0 + 16 * w; float zm2[4] = {0.f, 0.f, 0.f, 0.f}, zm1[4] = {0.f, 0.f, 0.f, 0.f};
        if (t0 + 16 * w != 0) { float p[4], q[4];
            unpack4(*(const v2u*)(proj + (size_t)(rs - 2) * NIN + 256 + c), p); unpack4(*(const v2u*)(proj + (size_t)(rs - 2) * NIN + 512 + c), q);
#pragma unroll
            for (int e = 0; e < 4; ++e) zm2[e] = p[e] * q[e];
            unpack4(*(const v2u*)(proj + (size_t)(rs - 1) * NIN + 256 + c), p); unpack4(*(const v2u*)(proj + (size_t)(rs - 1) * NIN + 512 + c), q);
#pragma unroll
            for (int e = 0; e < 4; ++e) zm1[e] = p[e] * q[e]; }
        const bool lastrows = (t0 + 128 == TP) && (w == 7);
#pragma unroll
        for (int tt = 0; tt < 16; ++tt) { const size_t ro = (size_t)(rs + tt) * NIN; float ab[4], ac[4], ax[4], z[4], y[4];
            unpack4(*(const v2u*)(proj + ro + c), ab); unpack4(*(const v2u*)(proj + ro + 256 + c), ac); unpack4(*(const v2u*)(proj + ro + 512 + c), ax);
#pragma unroll
            for (int e = 0; e < 4; ++e) { z[e] = ac[e] * ax[e]; y[e] = ab[e] * (zm2[e] * w0[e] + zm1[e] * w1[e] + z[e] * w2[e]); zm2[e] = zm1[e]; zm1[e] = z[e]; }
            v2u o; o.x = pk2(y[0], y[1]); o.y = pk2(y[2], y[3]); *(v2u*)(mix + (size_t)(rs + tt) * D + c) = o;
            if (tt >= 14 && lastrows) { const f32x4 zz = {z[0], z[1], z[2], z[3]}; *(f32x4*)(a.out + O_CP + ((size_t)(l * BP + bb) * 2 + (tt - 14)) * 256 + c) = zz; }
        }
    } else {
        const int wl = 2 << (cg >> 4);
#pragma unroll 1
        for (int sp = 0; sp < 2; ++sp) { const int tl0 = 8 * (2 * w + sp), rs = r0 + tl0;
            float cs[24][4];
            float ev[8][4];
#pragma unroll
            for (int e = 0; e < 4; ++e) cs[0][e] = 0.f;
#pragma unroll
            for (int k = -15; k < 8; ++k) { float p[4] = {0.f, 0.f, 0.f, 0.f};
                if (k >= 0 || t0 + tl0 + k >= 0) unpack4(*(const v2u*)(proj + (size_t)(rs + k) * NIN + 1792 + c), p);
#pragma unroll
                for (int e = 0; e < 4; ++e) { cs[k + 16][e] = cs[k + 15][e] + p[e]; if (k >= 0) ev[k][e] = p[e]; } }
#pragma unroll
            for (int tt = 0; tt < 8; ++tt) { const int tp = t0 + tl0 + tt + 1; const float cnt = (float)(tp < wl ? tp : wl); float dv[4];
#pragma unroll
                for (int e = 0; e < 4; ++e) { const float lo = wl == 2 ? cs[tt + 14][e] : wl == 4 ? cs[tt + 12][e] : wl == 8 ? cs[tt + 8][e] : cs[tt][e];
                    dv[e] = (cs[tt + 16][e] - lo) / cnt - ev[tt][e]; }
                v2u o; o.x = pk2(dv[0], dv[1]); o.y = pk2(dv[2], dv[3]); *(LAS v2u*)(DT + (tl0 + tt) * DT_RS + 2 * c) = o;
                if (t0 + 128 == TP && tl0 + tt >= 113) { const f32x4 pv = {ev[tt][0], ev[tt][1], ev[tt][2], ev[tt][3]}; *(f32x4*)(a.out + O_PP + ((size_t)(l * BP + bb) * 15 + (tl0 + tt - 113)) * 256 + c) = pv; }
            }
        }
    }
    LDS_WAIT(); __syncthreads();
    const int g = lane >> 4, i16 = lane & 15;
    {
        const int hl = w >> 1, dh = w & 1, h = hh * 4 + hl, q = i16 >> 2, p = i16 & 3;
        f32x4 acc[2][8];
#pragma unroll
        for (int dt = 0; dt < 2; ++dt)
#pragma unroll
            for (int it = 0; it < 8; ++it) acc[dt][it] = (f32x4){0.f, 0.f, 0.f, 0.f};
        const LAS unsigned char* vbase = VN + (8 * g + q) * VN_RS + (hl * 64 + dh * 32 + 4 * p) * 2;
        const bf16* wbase = WT + ((size_t)h * 128 + i16) * 128 + 8 * g;
#pragma unroll
        for (int ks = 0; ks < 4; ++ks) { bf16x8 Af[2];
#pragma unroll
            for (int dt = 0; dt < 2; ++dt) { const s16x4 lo = vtr(vbase + (32 * ks) * VN_RS + dt * 32), hi = vtr(vbase + (32 * ks + 4) * VN_RS + dt * 32);
                Af[dt] = (bf16x8){lo[0], lo[1], lo[2], lo[3], hi[0], hi[1], hi[2], hi[3]}; }
#pragma unroll
            for (int it = 2 * ks; it < 8; ++it) { const bf16x8 Bf = *(const bf16x8*)(wbase + (size_t)it * 16 * 128 + 32 * ks);
#pragma unroll
                for (int dt = 0; dt < 2; ++dt) acc[dt][it] = __builtin_amdgcn_mfma_f32_16x16x32_bf16(Af[dt], Bf, acc[dt][it], 0, 0, 0); } }
        const float* bsr = a.in[13] + (l * 8 + h) * 128;
#pragma unroll
        for (int it = 0; it < 8; ++it) { const int i = it * 16 + i16; const float bs = bsr[i]; const size_t ro = (size_t)(r0 + i);
#pragma unroll
            for (int dt = 0; dt < 2; ++dt) { const int ch = h * 64 + dh * 32 + dt * 16 + 4 * g; float u[4]; unpack4(*(const v2u*)(proj + ro * NIN + 768 + ch), u);
                const f32x4 s = acc[dt][it] + bs; v2u o; o.x = pk2(u[0] * s[0], u[1] * s[1]); o.y = pk2(u[2] * s[2], u[3] * s[3]); *(v2u*)(mix + ro * D + 256 + ch) = o; } }
    }
    if (hh == 1) {
        const int g4 = w >> 1, th = w & 1;
        f32x4 pacc[4][4];
#pragma unroll
        for (int x = 0; x < 4; ++x)
#pragma unroll
            for (int y = 0; y < 4; ++y) pacc[x][y] = (f32x4){0.f, 0.f, 0.f, 0.f};
#pragma unroll
        for (int ks = 0; ks < 2; ++ks) { bf16x8 Af[4];
#pragma unroll
            for (int ddt = 0; ddt < 4; ++ddt) Af[ddt] = *(const bf16x8*)(PWT + ((size_t)(g4 * 64 + ddt * 16 + i16)) * 64 + 32 * ks + 8 * g);
#pragma unroll
            for (int tt = 0; tt < 4; ++tt) { const bf16x8 Bf = *(const LAS bf16x8*)(DT + (th * 64 + tt * 16 + i16) * DT_RS + (g4 * 64 + 32 * ks + 8 * g) * 2);
#pragma unroll
                for (int ddt = 0; ddt < 4; ++ddt) pacc[ddt][tt] = __builtin_amdgcn_mfma_f32_16x16x32_bf16(Af[ddt], Bf, pacc[ddt][tt], 0, 0, 0); } }
#pragma unroll
        for (int ddt = 0; ddt < 4; ++ddt) { const int ch = g4 * 64 + ddt * 16 + 4 * g; const f32x4 ps = *(const f32x4*)(a.in[15] + l * 256 + ch);
#pragma unroll
            for (int tt = 0; tt < 4; ++tt) { const int t = th * 64 + tt * 16 + i16; const f32x4 y = pacc[ddt][tt] * ps;
                v2u o; o.x = pk2(y[0], y[1]); o.y = pk2(y[2], y[3]); *(v2u*)(mix + (size_t)(r0 + t) * D + 768 + ch) = o; } }
    }
    LDS_WAIT(); __syncthreads();
}

__device__ __forceinline__ void mixer_phase(Frame& F, const Args& a, int l, const bf16* proj, bf16* mix) {
    const bf16* WT = (const bf16*)(a.ws + WS_WTRIL) + (size_t)l * 8 * 128 * 128; const bf16* PWT = (const bf16*)(a.ws + WS_PWT) + (size_t)l * 4 * 64 * 64;
    conv_phase(F, a, l, proj, mix, MP / 8, M / 8);
    pool_phase(F, a, l, proj, mix, MP / 8, M / 8);
    { const int gw = F.vcu * NWAVES + F.wave, NGW = F.G * NWAVES; for (int b = gw; b < BS; b += NGW) sgu_sample_item(F, a, l, proj, mix, b); }
    for (int unit = F.vcu; unit < (MP / 128) * 2; unit += F.G) mixer_prompt_unit(F, a, l, proj, mix, WT, PWT, unit);
}

constexpr int N_PHASES = 3 + 7 * NL;
__global__ void __launch_bounds__(NWAVES * 64, 2) skel_fwd(Args args) {
    extern __shared__ __attribute__((aligned(16))) unsigned char lds[];
    Frame F;
    F.lds = (LAS unsigned char*)lds; F.MISC = (volatile LAS unsigned*)(F.lds + MISC_OFF);
    F.tid = threadIdx.x; F.lane = F.tid & 63; F.wave = __builtin_amdgcn_readfirstlane(F.tid >> 6);
    F.G = gridDim.x; { const int bx = blockIdx.x; F.vcu = (F.G % 8 == 0) ? (bx % 8) * (F.G / 8) + bx / 8 : bx; }
    unsigned char* ws = args.ws; F.ctl = (gu32*)(ws + WS_CTL);
    for (int u = F.tid; u < LDSCTL_BYTES / 4; u += NWAVES * 64) ((LAS unsigned*)(F.lds + LDSCTL_OFF))[u] = 0u;
    __syncthreads();
    const int lo = args.ph_lo, hi = args.ph_hi;
    XcdBarrier bar; bar.bar = (unsigned*)(F.ctl + CW_BAR); bar.x = 0; bar.st = nullptr;
    if (hi - lo > 1) bar = xcd_barrier_post((unsigned*)(F.ctl + CW_BAR), F.MISC + 8);
#define IN(k) (lo <= (k) && (k) < hi)
#define FRESH() do { int t_ = threadIdx.x; asm volatile("" : "+v"(t_)); F.tid = t_; F.lane = t_ & 63; } while (0)
#define SEAM(k) do { if (IN(k) && IN((k) + 1)) xcd_barrier(bar); } while (0)
    bf16* const WIN = (bf16*)(ws + WS_WIN); bf16* const WOUT = (bf16*)(ws + WS_WOUT); bf16* const WUP = (bf16*)(ws + WS_WUP); bf16* const WDN = (bf16*)(ws + WS_WDN);
    float* const MOD = (float*)(ws + WS_MOD); bf16* const HA = (bf16*)(ws + WS_HA); bf16* const PROJ = (bf16*)(ws + WS_PROJ); bf16* const MIX = (bf16*)(ws + WS_MIX); bf16* const HID = (bf16*)(ws + WS_HID);
    float* const Y = args.out;

#ifndef DIS_PRO
    if (IN(0)) { FRESH(); p0_prologue(F, args); SEAM(0); }
#endif
    if (IN(1)) {
        pg8::Gemm g{(const bf16*)(ws + WS_AC), (const bf16*)(ws + WS_WADA), NMODROW, MODLD, D}; pg8::StaticOrder S; S.init(NMODROW, MODLD, F.G, (int)blockIdx.x);
        pg8::EpiF32 E{MOD, MODLD, args.in[7]};
        pg8::gemm_phase<pg8::EpiF32, pg8::StaticOrder, true, true>(F.lds + RING_OFF, g, S, E); SEAM(1); }
    if (IN(2)) { FRESH(); modulate_rows(F, args.in[0], args.in[1], MOD + 0, MOD + 1024, HA); SEAM(2); }
#pragma unroll 1
    for (int l = 0; l < NL; ++l) {
        const int pb = 3 + 7 * l; const float* modl = MOD + (size_t)l * NMOD;
        if (IN(pb + 0)) { pg8::Gemm g{HA, WIN + (size_t)l * NIN * D, M, NIN, D}; pg8::StaticOrder S; S.init(M, NIN, F.G, (int)blockIdx.x);
            pg8::EpiBf16<0> E{PROJ, NIN, nullptr, 0, 0, 1.f};
            pg8::gemm_phase<pg8::EpiBf16<0>, pg8::StaticOrder, true, true>(F.lds + RING_OFF, g, S, E); SEAM(pb + 0); }
        if (IN(pb + 1)) {
#ifdef MIXER_V1
            FRESH(); conv_phase(F, args, l, PROJ, MIX, 0, M / 8); FRESH(); pool_phase(F, args, l, PROJ, MIX, 0, M / 8); FRESH(); sgu_phase(F, args, l, PROJ, MIX);
#else
            FRESH(); mixer_phase(F, args, l, PROJ, MIX);
#endif
            SEAM(pb + 1); }
        if (IN(pb + 2)) { pg8::Gemm g{MIX, WOUT + (size_t)l * D * D, M, D, D}; pg8::StaticOrder S; S.init(M, D, F.G, (int)blockIdx.x);
            pg8::EpiRes E{l == 0 ? args.in[0] : Y, l == 0 ? args.in[1] : Y + (size_t)MP * D, Y, modl + 2048, DN_ALPHA};
            pg8::gemm_phase<pg8::EpiRes, pg8::StaticOrder, true, true>(F.lds + RING_OFF, g, S, E); SEAM(pb + 2); }
        if (IN(pb + 3)) { FRESH(); ln_rows(F, Y, args.in[17] + l * D, args.in[18] + l * D, modl + 3072, modl + 4096, HA); SEAM(pb + 3); }
        if (IN(pb + 4)) { pg8::Gemm g{HA, WUP + (size_t)l * FF * D, M, FF, D}; pg8::StaticOrder S; S.init(M, FF, F.G, (int)blockIdx.x);
            pg8::EpiBf16<2> E{HID, FF, nullptr, 0, 0, 1.f};
            pg8::gemm_phase<pg8::EpiBf16<2>, pg8::StaticOrder, true, true>(F.lds + RING_OFF, g, S, E); SEAM(pb + 4); }
        if (IN(pb + 5)) { pg8::Gemm g{HID, WDN + (size_t)l * D * FF, M, D, FF}; pg8::StaticOrder S; S.init(M, D, F.G, (int)blockIdx.x);
            pg8::EpiRes E{Y, Y + (size_t)MP * D, Y, modl + 5120, DN_ALPHA};
            pg8::gemm_phase<pg8::EpiRes, pg8::StaticOrder, true, true>(F.lds + RING_OFF, g, S, E); SEAM(pb + 5); }
        if (IN(pb + 6)) { FRESH(); const bool more = (l + 1 < NL);
            ln_rows(F, Y, args.in[21] + l * D, args.in[22] + l * D, modl + NMOD + 0, modl + NMOD + 1024, more ? HA : nullptr); SEAM(pb + 6); }
    }
#undef IN
#undef SEAM
}

#ifndef MK_ONE_LAUNCH
#define MK_ONE_LAUNCH 1
#endif
extern "C" void kernel_launch(void* const* d_in, const int* in_sizes, int n_in, void* d_out, int out_size, void* d_ws, size_t ws_size, hipStream_t stream) {
    static int grid = 0;
    if (grid == 0) {
        if (n_in != 23 || (size_t)out_size != O_END || ws_size < WS_END) { fprintf(stderr, "kernel_launch: unexpected shapes: n_in %d out %d ws %zu\n", n_in, out_size, ws_size); grid = -1; return; }
        int dev = 0, cus = 0, per_cu = 0;
        if (hipGetDevice(&dev) != hipSuccess || hipDeviceGetAttribute(&cus, hipDeviceAttributeMultiprocessorCount, dev) != hipSuccess) { grid = -1; return; }
        if (hipFuncSetAttribute((const void*)skel_fwd, hipFuncAttributeMaxDynamicSharedMemorySize, LDS_BYTES) != hipSuccess) { fprintf(stderr, "kernel_launch: hipFuncSetAttribute failed\n"); grid = -1; return; }
        if (hipOccupancyMaxActiveBlocksPerMultiprocessor(&per_cu, (const void*)skel_fwd, NWAVES * 64, LDS_BYTES) != hipSuccess || per_cu < 1) { fprintf(stderr, "kernel_launch: occupancy query says %d\n", per_cu); per_cu = 1; }
        (void)hipGetLastError();
        grid = cus * (per_cu < 1 ? 1 : 1);
    }
    if (grid < 0) return;
    if (hipMemsetAsync((char*)d_ws + WS_CTL, 0, CTL_ZERO_BYTES, stream) != hipSuccess) return;
    Args a{};
    for (int i = 0; i < 23; ++i) a.in[i] = (const float*)d_in[i];
    a.out = (float*)d_out; a.ws = (unsigned char*)d_ws;
#if MK_ONE_LAUNCH
    a.ph_lo = 0; a.ph_hi = N_PHASES;
    void* kargs[] = {(void*)&a};
    hipError_t e = hipLaunchCooperativeKernel((const void*)skel_fwd, dim3(grid), dim3(NWAVES * 64), kargs, LDS_BYTES, stream);
    if (e != hipSuccess) fprintf(stderr, "kernel_launch: cooperative launch failed: %s (grid %d)\n", hipGetErrorString(e), grid);
#else
    for (int p = 0; p < N_PHASES; ++p) { a.ph_lo = p; a.ph_hi = p + 1; hipLaunchKernelGGL(skel_fwd, dim3(grid), dim3(NWAVES * 64), LDS_BYTES, stream, a); }
#endif
}
```

```cpp
#include <hip/hip_runtime.h>
#include <cstdio>
#include <cstdint>
namespace pg8 {
#define PG8_LAS __attribute__((address_space(3)))
typedef unsigned short bf16_t;
typedef short bf16x8 __attribute__((ext_vector_type(8)));
typedef float f32x4 __attribute__((ext_vector_type(4)));
typedef unsigned u32x4 __attribute__((ext_vector_type(4)));
constexpr int BM = 256, BK = 64, HALF = 128, HTB = HALF * BK * 2  , STAGE_BYTES = 8 * HTB, NXCD = 8, WGM = 8;

__host__ __device__ __forceinline__ int lds_byte(int r, int c) { const int st = (r >> 4) * 2 + (c >> 5), rr = r & 15, cc = c & 31, ob = rr * 64 + cc * 2; return st * 1024 + (ob ^ (((ob >> 9) & 1) << 5)); }
__host__ __device__ __forceinline__ void stage_rc(int b, int& R, int& C) { const int st = b / 1024, sb = b % 1024, swz = sb ^ (((sb >> 9) & 1) << 5); R = (st >> 1) * 16 + swz / 64; C = (st & 1) * 32 + (swz % 64) / 2; }
__host__ __device__ __forceinline__ int perm32(int rho) { const int n = rho >> 4, i = rho & 15; return 8 * (i >> 2) + 4 * n + (i & 3); }

struct Unit { int pm, pn; };
struct Gemm { const bf16_t* A; const bf16_t* Bt; int M, N, K; };

struct StaticOrder {
    int nM, nN, nwg, G, c;
    __host__ __device__ void init(int M, int N, int G_, int c_) { nM = M / BM; nN = N / BM; nwg = nM * nN; G = G_; c = c_; }
    __host__ __device__ bool next(int i, Unit& u) const {
        const long L = (long)i * G + c; if (L >= nwg) return false;
        int wgid = (int)L; { const int q = nwg / NXCD, r = nwg % NXCD, xcd = wgid % NXCD, off = wgid / NXCD; wgid = (xcd < r ? xcd * (q + 1) : r * (q + 1) + (xcd - r) * q) + off; }
        const int nig = WGM * nN, gid = wgid / nig, fm = gid * WGM, gsz = (nM - fm) < WGM ? (nM - fm) : WGM;
        u.pm = fm + ((wgid % nig) % gsz); u.pn = (wgid % nig) / gsz; return true;
    }
    __device__ __forceinline__ void a_ready(const Unit&) const {}
    __device__ __forceinline__ void done(const Unit&) const {}
};

typedef float f32x2c __attribute__((ext_vector_type(2))); typedef __bf16 bf16x2c __attribute__((ext_vector_type(2)));
__device__ __forceinline__ unsigned cvt_pk_bf16(float lo, float hi) { const f32x2c v = {lo, hi}; return __builtin_bit_cast(unsigned, __builtin_convertvector(v, bf16x2c)); }
typedef float f32x2 __attribute__((ext_vector_type(2)));
__device__ __forceinline__ f32x2 gelu_pk(f32x2 v) {
    const f32x2 av = __builtin_elementwise_abs(v), d = av * 0.2316418882f + 1.0f;
    f32x2 t; t.x = __builtin_amdgcn_rcpf(d.x); t.y = __builtin_amdgcn_rcpf(d.y);
    f32x2 q = t * 0.5307027145f + (-0.7265760135f); q = q * t + 0.7107068705f; q = q * t + (-0.142248368f); q = q * t + 0.127414796f; q = q * t;
    const f32x2 s = (v * v) * (-0.72134752044f);
    f32x2 e; e.x = __builtin_amdgcn_exp2f(s.x); e.y = __builtin_amdgcn_exp2f(s.y);
    const f32x2 m = v * (q * e), r = v - m;
    f32x2 o; o.x = v.x < 0.f ? m.x : r.x; o.y = v.y < 0.f ? m.y : r.y; return o;
}

struct EpiF32 {
    static constexpr bool PERM = false, AFTER_DRAIN = false;
    float* C; int ldc; const float* bias;
    __device__ __forceinline__ void operator()(const f32x4 (&acc)[2][2][4][2], const Unit& u, int wr, int wc, int fr, int fq) const {
        const int row0 = u.pm * BM + wr * 64 + fr, col0 = u.pn * BM + wc * 32 + 4 * fq;
        f32x4 bv[2][2];
#pragma unroll
        for (int bj = 0; bj < 2; ++bj)
#pragma unroll
            for (int n = 0; n < 2; ++n) bv[bj][n] = bias ? *(const f32x4*)(bias + col0 + bj * HALF + n * 16) : (f32x4){0.f, 0.f, 0.f, 0.f};
#pragma unroll
        for (int ai = 0; ai < 2; ++ai)
#pragma unroll
            for (int m = 0; m < 4; ++m) { float* rowp = C + (size_t)(row0 + ai * HALF + m * 16) * ldc + col0;
#pragma unroll
                for (int bj = 0; bj < 2; ++bj)
#pragma unroll
                    for (int n = 0; n < 2; ++n) *(f32x4*)(rowp + bj * HALF + n * 16) = acc[ai][bj][m][n] + bv[bj][n]; }
    }
};
template <int ACT  > struct EpiBf16 {
    static constexpr bool PERM = true, AFTER_DRAIN = false; static_assert(ACT == 0 || ACT == 1 || ACT == 2, "EpiBf16: ACT is 0 (none), 1 (gelu_pk) or 2 (squared relu)");
    bf16_t* O; int ldc; const float* bias; int split_cols; size_t split_stride; float scale0;
    __device__ __forceinline__ void operator()(const f32x4 (&acc)[2][2][4][2], const Unit& u, int wr, int wc, int fr, int fq) const {
        const int row0 = u.pm * BM + wr * 64 + fr; int colt = u.pn * BM; bf16_t* base = O;
        float sc = 1.f; if (split_cols) { const int t = colt / split_cols; base += (size_t)t * split_stride; colt -= t * split_cols; if (t == 0) sc = scale0; }
        const int col0 = colt + wc * 32 + 8 * fq, bcol0 = u.pn * BM + wc * 32 + 8 * fq;
        f32x4 bv[2][2];
#pragma unroll
        for (int bj = 0; bj < 2; ++bj)
#pragma unroll
            for (int n = 0; n < 2; ++n) bv[bj][n] = bias ? *(const f32x4*)(bias + bcol0 + bj * HALF + 4 * n) : (f32x4){0.f, 0.f, 0.f, 0.f};
#pragma unroll
        for (int ai = 0; ai < 2; ++ai)
#pragma unroll
            for (int m = 0; m < 4; ++m) { bf16_t* rowp = base + (size_t)(row0 + ai * HALF + m * 16) * ldc + col0;
#pragma unroll
                for (int bj = 0; bj < 2; ++bj) { f32x4 v0 = acc[ai][bj][m][0] + bv[bj][0], v1 = acc[ai][bj][m][1] + bv[bj][1];
                    if (ACT == 1) { f32x2 a = gelu_pk((f32x2){v0[0], v0[1]}), b = gelu_pk((f32x2){v0[2], v0[3]}), c = gelu_pk((f32x2){v1[0], v1[1]}), d = gelu_pk((f32x2){v1[2], v1[3]});
                        v0 = (f32x4){a.x, a.y, b.x, b.y}; v1 = (f32x4){c.x, c.y, d.x, d.y}; }
                    if (ACT == 2) { v0 = __builtin_elementwise_max(v0, (f32x4){0.f, 0.f, 0.f, 0.f}); v1 = __builtin_elementwise_max(v1, (f32x4){0.f, 0.f, 0.f, 0.f}); v0 = v0 * v0; v1 = v1 * v1; }
                    v0 = v0 * sc; v1 = v1 * sc; u32x4 w; w.x = cvt_pk_bf16(v0[0], v0[1]); w.y = cvt_pk_bf16(v0[2], v0[3]); w.z = cvt_pk_bf16(v1[0], v1[1]); w.w = cvt_pk_bf16(v1[2], v1[3]);
                    *(u32x4*)(rowp + bj * HALF) = w; } }
    }
};

struct PanelStats {
    unsigned* xbuf;
    unsigned* cnt;
    unsigned* tmo;
    int ntn; float eps;
    unsigned code;
    __device__ __forceinline__ bool run(const f32x4 (&v)[2][2][4][2], const Unit& u, int wr, int wc, int fr, int fq, PG8_LAS unsigned char* lds, int wid, int lane) const {
        typedef float f32x2v __attribute__((ext_vector_type(2)));
        PG8_LAS f32x2v* P = (PG8_LAS f32x2v*)lds;
        PG8_LAS f32x2v* S = (PG8_LAS f32x2v*)(lds + 8192);
        PG8_LAS unsigned* flag = (PG8_LAS unsigned*)(lds + 8192 + 2048);
#pragma unroll
        for (int ai = 0; ai < 2; ++ai)
#pragma unroll
            for (int m = 0; m < 4; ++m) {
                float s = 0.f;
#pragma unroll
                for (int bj = 0; bj < 2; ++bj)
#pragma unroll
                    for (int n = 0; n < 2; ++n) { const f32x4 x = v[ai][bj][m][n]; s += (x[0] + x[1]) + (x[2] + x[3]); }
                s += __shfl_xor(s, 16); s += __shfl_xor(s, 32);
                const float mw = s * (1.0f / 64.0f); float q = 0.f;
#pragma unroll
                for (int bj = 0; bj < 2; ++bj)
#pragma unroll
                    for (int n = 0; n < 2; ++n) { const f32x4 d = v[ai][bj][m][n] - mw; q += (d[0] * d[0] + d[1] * d[1]) + (d[2] * d[2] + d[3] * d[3]); }
                q += __shfl_xor(q, 16); q += __shfl_xor(q, 32);
                if (fq == 0) P[(ai * HALF + wr * 64 + m * 16 + fr) * 4 + wc] = (f32x2v){mw, q};
            }
        asm volatile("s_waitcnt lgkmcnt(0)" ::: "memory"); __builtin_amdgcn_s_barrier(); asm volatile("" ::: "memory");
#if defined(BROKEN_EXCHANGE_NO_WAIT)
#warning BROKEN CONTROL BUILD: the row-statistics exchange does not wait; results are wrong by design
        if (blockIdx.x >= 64) { const long long t0_ = clock64(); while (clock64() - t0_ < 60000) __builtin_amdgcn_s_sleep(8); }
#endif
        const int row = wid * 32 + (lane & 31);
        if (lane < 32) {
            const f32x2v a = P[row * 4 + 0], b = P[row * 4 + 1], c = P[row * 4 + 2], d = P[row * 4 + 3];
            const float mt = (a.x + b.x + c.x + d.x) * 0.25f;
            const float da = a.x - mt, db = b.x - mt, dc = c.x - mt, dd = d.x - mt;
            const float m2 = (a.y + b.y) + (c.y + d.y) + 64.0f * ((da * da + db * db) + (dc * dc + dd * dd));
            unsigned long long* slot = (unsigned long long*)xbuf + ((size_t)(u.pm * BM + row) * 4 + u.pn);
            __hip_atomic_store(slot, ((unsigned long long)__float_as_uint(m2) << 32) | __float_as_uint(mt), __ATOMIC_RELAXED, __HIP_MEMORY_SCOPE_AGENT);
        }
        asm volatile("s_waitcnt vmcnt(0)" ::: "memory");
        if (lane == 0) __hip_atomic_fetch_add(cnt + 64 * u.pm, 1u, __ATOMIC_RELAXED, __HIP_MEMORY_SCOPE_AGENT);
        if (wid == 0) {
            bool dead = false; const unsigned long long t0 = __builtin_amdgcn_s_memrealtime(); const unsigned want = 8u * (unsigned)ntn;
            for (;;) {
#if defined(BROKEN_EXCHANGE_NO_WAIT)
                break;
#endif
                if ((unsigned)__builtin_amdgcn_readfirstlane(__hip_atomic_load(cnt + 64 * u.pm, __ATOMIC_RELAXED, __HIP_MEMORY_SCOPE_AGENT)) >= want) break;
                if (__builtin_amdgcn_s_memrealtime() - t0 > 2000000ull) {
                    if (lane == 0) { unsigned expect = 0u; __hip_atomic_compare_exchange_strong(tmo + 1, &expect, code | (unsigned)(u.pm & 0xff), __ATOMIC_RELAXED, __ATOMIC_RELAXED, __HIP_MEMORY_SCOPE_AGENT);
                                     __hip_atomic_store(tmo, 1u, __ATOMIC_RELAXED, __HIP_MEMORY_SCOPE_AGENT); }
                    dead = true; break; }
                __builtin_amdgcn_s_sleep(2);
            }
            __builtin_amdgcn_fence(__ATOMIC_ACQUIRE, "agent");
            if (lane == 0) flag[0] = dead ? 1u : 0u;
        }
        asm volatile("s_waitcnt vmcnt(0) lgkmcnt(0)" ::: "memory"); __builtin_amdgcn_s_barrier(); asm volatile("" ::: "memory");
        const bool bad = flag[0] != 0u;
        if (lane < 32) {
            const unsigned long long* slot = (const unsigned long long*)xbuf + (size_t)(u.pm * BM + row) * 4; float mt[4], m2[4]; float ms = 0.f;
#pragma unroll
            for (int t = 0; t < 4; ++t) { if (t < ntn) { const unsigned long long w = __hip_atomic_load(slot + t, __ATOMIC_RELAXED, __HIP_MEMORY_SCOPE_AGENT); mt[t] = __uint_as_float((unsigned)w); m2[t] = __uint_as_float((unsigned)(w >> 32)); } else { mt[t] = 0.f; m2[t] = 0.f; } ms += mt[t]; }
            const float mean = ms / (float)ntn; float q = 0.f;
#pragma unroll
            for (int t = 0; t < 4; ++t) if (t < ntn) { const float dm = mt[t] - mean; q += m2[t] + 256.0f * dm * dm; }
            S[row] = (f32x2v){mean, 1.0f / sqrtf(q / (256.0f * (float)ntn) + eps)};
        }
        asm volatile("s_waitcnt lgkmcnt(0)" ::: "memory"); __builtin_amdgcn_s_barrier(); asm volatile("" ::: "memory");
        return bad;
    }
};
struct EpiLnRes {
    static constexpr bool PERM = false, AFTER_DRAIN = true;
    const float* base; float* out; int ldc; const float* bias; PanelStats st; unsigned poison;
    __device__ __forceinline__ void fused(f32x4 (&acc)[2][2][4][2], const Unit& u, int wr, int wc, int fr, int fq, PG8_LAS unsigned char* lds, int wid, int lane) const {
        typedef float f32x2v __attribute__((ext_vector_type(2)));
        const PG8_LAS f32x2v* S = (const PG8_LAS f32x2v*)(lds + 8192);
        const int col0 = u.pn * BM + wc * 32 + 4 * fq;
#pragma unroll
        for (int bj = 0; bj < 2; ++bj)
#pragma unroll
            for (int n = 0; n < 2; ++n) { const f32x4 bv = bias ? *(const f32x4*)(bias + col0 + bj * HALF + n * 16) : (f32x4){0.f, 0.f, 0.f, 0.f};
#pragma unroll
                for (int ai = 0; ai < 2; ++ai)
#pragma unroll
                    for (int m = 0; m < 4; ++m) acc[ai][bj][m][n] += bv; }
        f32x4 pre[4][2][2];
#pragma unroll
        for (int m = 0; m < 4; ++m) { const size_t off = (size_t)(u.pm * BM + wr * 64 + m * 16 + fr) * ldc + col0;
#pragma unroll
            for (int bj = 0; bj < 2; ++bj)
#pragma unroll
                for (int n = 0; n < 2; ++n) pre[m][bj][n] = *(const f32x4*)(base + off + bj * HALF + n * 16); }
        const bool bad = st.run(acc, u, wr, wc, fr, fq, lds, wid, lane) || poison != 0u;
        const float qnan = __builtin_nanf("");
#pragma unroll
        for (int ai = 0; ai < 2; ++ai)
#pragma unroll
            for (int m = 0; m < 4; ++m) { const int r = ai * HALF + wr * 64 + m * 16 + fr; const f32x2v sr = S[r]; const size_t off = (size_t)(u.pm * BM + r) * ldc + col0;
#pragma unroll
                for (int bj = 0; bj < 2; ++bj)
#pragma unroll
                    for (int n = 0; n < 2; ++n) { const f32x4 bs = ai == 0 ? pre[m][bj][n] : *(const f32x4*)(base + off + bj * HALF + n * 16); f32x4 o = bs + (acc[ai][bj][m][n] - sr.x) * sr.y;
                        if (bad) o = (f32x4){qnan, qnan, qnan, qnan}; *(f32x4*)(out + off + bj * HALF + n * 16) = o; }
                if (m & 1) asm volatile("" ::: "memory"); }
    }
};
struct EpiLnResLn {
    static constexpr bool PERM = false, AFTER_DRAIN = true;
    const float* base; float* out; bf16_t* xn; int ldc; const float* bias; PanelStats st1, st2; unsigned poison;
    __device__ __forceinline__ void fused(f32x4 (&acc)[2][2][4][2], const Unit& u, int wr, int wc, int fr, int fq, PG8_LAS unsigned char* lds, int wid, int lane) const {
        typedef float f32x2v __attribute__((ext_vector_type(2))); typedef unsigned u32x2v __attribute__((ext_vector_type(2)));
        const PG8_LAS f32x2v* S = (const PG8_LAS f32x2v*)(lds + 8192);
        const int col0 = u.pn * BM + wc * 32 + 4 * fq;
#pragma unroll
        for (int bj = 0; bj < 2; ++bj)
#pragma unroll
            for (int n = 0; n < 2; ++n) { const f32x4 bv = bias ? *(const f32x4*)(bias + col0 + bj * HALF + n * 16) : (f32x4){0.f, 0.f, 0.f, 0.f};
#pragma unroll
                for (int ai = 0; ai < 2; ++ai)
#pragma unroll
                    for (int m = 0; m < 4; ++m) acc[ai][bj][m][n] += bv; }
        bool bad = st1.run(acc, u, wr, wc, fr, fq, lds, wid, lane) || poison != 0u;
        const float qnan = __builtin_nanf("");
#pragma unroll
        for (int ai = 0; ai < 2; ++ai)
#pragma unroll
            for (int m = 0; m < 4; ++m) { const int r = ai * HALF + wr * 64 + m * 16 + fr; const f32x2v sr = S[r]; const size_t off = (size_t)(u.pm * BM + r) * ldc + col0;
#pragma unroll
                for (int bj = 0; bj < 2; ++bj)
#pragma unroll
                    for (int n = 0; n < 2; ++n) { const f32x4 bs = *(const f32x4*)(base + off + bj * HALF + n * 16); acc[ai][bj][m][n] = bs + (acc[ai][bj][m][n] - sr.x) * sr.y; }
                asm volatile("" : "+v"(acc[ai][0][m][0]), "+v"(acc[ai][0][m][1]), "+v"(acc[ai][1][m][0]), "+v"(acc[ai][1][m][1]));
                if (m & 1) asm volatile("" ::: "memory"); }
        const bool bad1 = bad;
        bad = st2.run(acc, u, wr, wc, fr, fq, lds, wid, lane) || bad;
#pragma unroll
        for (int ai = 0; ai < 2; ++ai)
#pragma unroll
            for (int m = 0; m < 4; ++m) { const int r = ai * HALF + wr * 64 + m * 16 + fr; const f32x2v sr = S[r]; const size_t off = (size_t)(u.pm * BM + r) * ldc + col0;
#pragma unroll
                for (int bj = 0; bj < 2; ++bj)
#pragma unroll
                    for (int n = 0; n < 2; ++n) { const f32x4 x1 = acc[ai][bj][m][n]; *(f32x4*)(out + off + bj * HALF + n * 16) = bad1 ? (f32x4){qnan, qnan, qnan, qnan} : x1;
                        const f32x4 o = (x1 - sr.x) * sr.y; u32x2v w; w.x = cvt_pk_bf16(o[0], o[1]); w.y = cvt_pk_bf16(o[2], o[3]);
                        if (bad) { w.x = 0x7fc07fc0u; w.y = 0x7fc07fc0u; } *(u32x2v*)(xn + off + bj * HALF + n * 16) = w; }
                asm volatile("" ::: "memory"); }
    }
};


struct EpiRes {
    static constexpr bool PERM = false, AFTER_DRAIN = false;
    const float* xp; const float* xs; float* out; const float* gate; float alpha;
    __device__ __forceinline__ void operator()(const f32x4 (&acc)[2][2][4][2], const Unit& u, int wr, int wc, int fr, int fq) const {
        const int row0 = u.pm * BM + wr * 64 + fr, col0 = u.pn * BM + wc * 32 + 4 * fq; const bool samp = u.pm >= 64;
#pragma unroll
        for (int ai = 0; ai < 2; ++ai)
#pragma unroll
            for (int m = 0; m < 4; ++m) { const int r = row0 + ai * HALF + m * 16;
                const float* xrow = samp ? xs + (size_t)(r - 16384) * 1024 : xp + (size_t)r * 1024;
                const int mr = samp ? 8 + ((r - 16384) >> 3) : (r >> 11);
                const float* grow = gate + (size_t)mr * 12288; float* orow = out + (size_t)r * 1024;
#pragma unroll
                for (int bj = 0; bj < 2; ++bj)
#pragma unroll
                    for (int n = 0; n < 2; ++n) { const int c = col0 + bj * HALF + n * 16; const f32x4 xv = *(const f32x4*)(xrow + c), gv = *(const f32x4*)(grow + c);
                        *(f32x4*)(orow + c) = xv * alpha + gv * acc[ai][bj][m][n]; }
                asm volatile("" ::: "memory"); }
    }
};
template <class Epi, class Sched, bool ALIGN_EPI = false, bool SP2 = false>
__device__ __forceinline__ void gemm_phase(PG8_LAS unsigned char* lds, const Gemm g, const Sched& S, const Epi& E) {
    int tid_ = threadIdx.x; asm volatile("" : "+v"(tid_));
    const int tid = tid_, wid = __builtin_amdgcn_readfirstlane(tid >> 6), lane = tid & 63, wr = wid >> 2, wc = wid & 3, fr = lane & 15, fq = lane >> 4;
    const int K = g.K, nt = K / BK;
    unsigned voffA[2], voffB[2];
#pragma unroll
    for (int i = 0; i < 2; ++i) { int R, C; stage_rc(tid * 16 + i * 8192, R, C); const int Rb = Epi::PERM ? ((R & ~31) + perm32(R & 31)) : R;
        voffA[i] = (unsigned)(R * K + C) * 2u; voffB[i] = (unsigned)(Rb * K + C) * 2u; }
    const size_t kstep = (size_t)(BK * 2);
    const size_t hstep = (size_t)HALF * K * 2;
    const size_t tstep = 2 * hstep;
    const unsigned ldsw = (unsigned)wid * 1024u;
    const int aoff = lds_byte(wr * 64 + fr, fq * 8), boff = lds_byte(wc * 32 + fr, fq * 8);
#define PG8_SA(b, h) (((b) * 2 + (h)) * HTB)
#define PG8_SB(b, h) ((4 + (b) * 2 + (h)) * HTB)
#define PG8_STAGE(bufoff, gbase, voff) do { _Pragma("unroll") for (int _i = 0; _i < 2; ++_i) \
        __builtin_amdgcn_global_load_lds((const unsigned*)((const char*)(gbase) + (voff)[_i]), (PG8_LAS unsigned*)(lds + (bufoff) + ldsw + _i * 8192), 16, 0, 0); } while (0)
#define PG8_LDA(dst, b, h) do { _Pragma("unroll") for (int m = 0; m < 4; ++m) _Pragma("unroll") for (int k = 0; k < 2; ++k) dst[m][k] = *(const PG8_LAS bf16x8*)(lds + PG8_SA(b, h) + aoff + m * 2048 + k * 1024); } while (0)
#define PG8_LDB(dst, b, h) do { _Pragma("unroll") for (int n = 0; n < 2; ++n) _Pragma("unroll") for (int k = 0; k < 2; ++k) dst[n][k] = *(const PG8_LAS bf16x8*)(lds + PG8_SB(b, h) + boff + n * 2048 + k * 1024); } while (0)
#define PG8_MMA(ai, bj, At, Bt) do { __builtin_amdgcn_s_setprio(1); _Pragma("unroll") for (int m = 0; m < 4; ++m) _Pragma("unroll") for (int n = 0; n < 2; ++n) _Pragma("unroll") for (int k = 0; k < 2; ++k) \
        acc[ai][bj][m][n] = __builtin_amdgcn_mfma_f32_16x16x32_bf16(Bt[n][k], At[m][k], acc[ai][bj][m][n], 0, 0, 0); __builtin_amdgcn_s_setprio(0); } while (0)
#define PG8_WAIT_V(n) asm volatile("s_waitcnt vmcnt(" #n ")" ::: "memory")
#define PG8_WAIT_L(n) asm volatile("s_waitcnt lgkmcnt(" #n ")" ::: "memory")
#define PG8_BAR __builtin_amdgcn_s_barrier()
#define PG8_SCHED __builtin_amdgcn_sched_barrier(0)
    Unit cur, nxt; int ui = 0;
    if (!S.next(0, cur)) return;
    f32x4 acc[2][2][4][2];
#pragma unroll
    for (int a = 0; a < 2; ++a)
#pragma unroll
        for (int b = 0; b < 2; ++b)
#pragma unroll
            for (int m = 0; m < 4; ++m)
#pragma unroll
                for (int n = 0; n < 2; ++n) acc[a][b][m][n] = (f32x4){0.f, 0.f, 0.f, 0.f};
    bf16x8 At[4][2], B0[2][2], B1[2][2];
    const char* cA = (const char*)g.A + (size_t)cur.pm * tstep; const char* cB = (const char*)g.Bt + (size_t)cur.pn * tstep;
    S.a_ready(cur);
    if constexpr (SP2) {
        PG8_STAGE(PG8_SB(0, 0), cB, voffB); PG8_STAGE(PG8_SB(0, 1), cB + hstep, voffB); PG8_STAGE(PG8_SA(0, 0), cA, voffA); PG8_STAGE(PG8_SA(0, 1), cA + hstep, voffA);
        if (wr == 1) PG8_BAR;
        PG8_WAIT_V(2); PG8_BAR;
        PG8_STAGE(PG8_SB(1, 0), cB + kstep, voffB); PG8_STAGE(PG8_SA(1, 0), cA + kstep, voffA); PG8_STAGE(PG8_SB(1, 1), cB + hstep + kstep, voffB);
        PG8_WAIT_V(6); PG8_BAR;
    } else {
        PG8_STAGE(PG8_SB(0, 0), cB, voffB); PG8_STAGE(PG8_SA(0, 0), cA, voffA); PG8_STAGE(PG8_SB(0, 1), cB + hstep, voffB); PG8_STAGE(PG8_SA(0, 1), cA + hstep, voffA);
        if (wr == 1) PG8_BAR;
        PG8_WAIT_V(4); PG8_BAR;
        PG8_STAGE(PG8_SB(1, 0), cB + kstep, voffB); PG8_STAGE(PG8_SA(1, 0), cA + kstep, voffA); PG8_STAGE(PG8_SB(1, 1), cB + hstep + kstep, voffB);
        PG8_WAIT_V(6); PG8_BAR;
    }
    for (;;) {
        const bool has_next = S.next(ui + 1, nxt);
        const char* nA = has_next ? (const char*)g.A + (size_t)nxt.pm * tstep : cA; const char* nB = has_next ? (const char*)g.Bt + (size_t)nxt.pn * tstep : cB;
        for (int t = 0; t < nt; t += 2) {
            const bool last = (t == nt - 2);
            const char* a1 = cA + (size_t)(t + 1) * kstep;
            const char* a2 = last ? nA : cA + (size_t)(t + 2) * kstep; const char* b2 = last ? nB : cB + (size_t)(t + 2) * kstep;
            const char* a3 = a2 + kstep; const char* b3 = b2 + kstep;
            if (last && has_next) S.a_ready(nxt);
            if constexpr (SP2) {
            PG8_LDB(B0, 0, 0); PG8_LDB(B1, 0, 1); PG8_SCHED; PG8_LDA(At, 0, 0); PG8_STAGE(PG8_SA(1, 1), a1 + hstep, voffA);
            PG8_WAIT_V(8); PG8_WAIT_L(0); PG8_BAR; PG8_MMA(0, 0, At, B0); PG8_MMA(0, 1, At, B1); PG8_BAR; PG8_SCHED;
            PG8_LDA(At, 0, 1); PG8_STAGE(PG8_SB(0, 0), b2, voffB); PG8_STAGE(PG8_SB(0, 1), b2 + hstep, voffB); PG8_STAGE(PG8_SA(0, 0), a2, voffA);
            PG8_WAIT_V(8); PG8_WAIT_L(0); PG8_BAR; PG8_MMA(1, 0, At, B0); PG8_MMA(1, 1, At, B1); PG8_BAR; PG8_SCHED;
            PG8_LDB(B0, 1, 0); PG8_LDB(B1, 1, 1); PG8_SCHED; PG8_LDA(At, 1, 0); PG8_STAGE(PG8_SA(0, 1), a2 + hstep, voffA);
            PG8_WAIT_V(8); PG8_WAIT_L(0); PG8_BAR; PG8_MMA(0, 0, At, B0); PG8_MMA(0, 1, At, B1); PG8_BAR; PG8_SCHED;
            PG8_LDA(At, 1, 1); PG8_STAGE(PG8_SB(1, 0), b3, voffB); PG8_STAGE(PG8_SB(1, 1), b3 + hstep, voffB); PG8_STAGE(PG8_SA(1, 0), a3, voffA);
            PG8_WAIT_V(8); PG8_WAIT_L(0); PG8_BAR; PG8_MMA(1, 0, At, B0); PG8_MMA(1, 1, At, B1); PG8_BAR; PG8_SCHED;
            } else {
            PG8_LDB(B0, 0, 0); PG8_SCHED; PG8_LDA(At, 0, 0); PG8_STAGE(PG8_SA(1, 1), a1 + hstep, voffA);
            PG8_WAIT_L(8); PG8_BAR; PG8_WAIT_L(0); PG8_MMA(0, 0, At, B0); PG8_BAR; PG8_SCHED;
            PG8_LDB(B1, 0, 1); PG8_STAGE(PG8_SB(0, 0), b2, voffB);
            PG8_BAR; PG8_WAIT_L(0); PG8_MMA(0, 1, At, B1); PG8_BAR;
            PG8_LDA(At, 0, 1); PG8_STAGE(PG8_SA(0, 0), a2, voffA);
            PG8_BAR; PG8_WAIT_L(0); PG8_MMA(1, 0, At, B0); PG8_BAR; PG8_SCHED;
            PG8_STAGE(PG8_SB(0, 1), b2 + hstep, voffB);
            PG8_WAIT_V(6); PG8_BAR; PG8_MMA(1, 1, At, B1); PG8_BAR;
            PG8_LDB(B0, 1, 0); PG8_SCHED; PG8_LDA(At, 1, 0); PG8_STAGE(PG8_SA(0, 1), a2 + hstep, voffA);
            PG8_WAIT_L(8); PG8_BAR; PG8_WAIT_L(0); PG8_MMA(0, 0, At, B0); PG8_BAR; PG8_SCHED;
            PG8_LDB(B1, 1, 1); PG8_STAGE(PG8_SB(1, 0), b3, voffB);
            PG8_BAR; PG8_WAIT_L(0); PG8_MMA(0, 1, At, B1); PG8_BAR;
            PG8_LDA(At, 1, 1); PG8_STAGE(PG8_SA(1, 0), a3, voffA);
            PG8_BAR; PG8_WAIT_L(0); PG8_MMA(1, 0, At, B0); PG8_BAR; PG8_SCHED;
            PG8_STAGE(PG8_SB(1, 1), b3 + hstep, voffB);
            PG8_WAIT_V(6); PG8_BAR; PG8_MMA(1, 1, At, B1); PG8_BAR;
            }
        }
        if constexpr (ALIGN_EPI) { if (wr == 0) PG8_BAR; }
        if constexpr (!Epi::AFTER_DRAIN) { E(acc, cur, wr, wc, fr, fq); S.done(cur); }
        if (!has_next) break;
#pragma unroll
        for (int a = 0; a < 2; ++a)
#pragma unroll
            for (int b = 0; b < 2; ++b)
#pragma unroll
                for (int m = 0; m < 4; ++m)
#pragma unroll
                    for (int n = 0; n < 2; ++n) acc[a][b][m][n] = (f32x4){0.f, 0.f, 0.f, 0.f};
        cur = nxt; cA = nA; cB = nB; ++ui;
        if constexpr (ALIGN_EPI) { if (wr == 1) PG8_BAR; }
    }
    PG8_WAIT_V(0);
    if constexpr (!ALIGN_EPI) { if (wr == 0) PG8_BAR; }
    PG8_BAR;
    if constexpr (Epi::AFTER_DRAIN) { E.fused(acc, cur, wr, wc, fr, fq, lds, wid, lane); S.done(cur); }
#undef PG8_SA
#undef PG8_SB
#undef PG8_STAGE
#undef PG8_LDA
#undef PG8_LDB
#undef PG8_MMA
#undef PG8_WAIT_V
#undef PG8_WAIT_L
#undef PG8_BAR
#undef PG8_SCHED
}
}


constexpr int NWAVES = 8;
constexpr int D = 1024, BP = 8, TP = 2048, BS = 128, TS = 8, MP = BP * TP, MS = BS * TS, M = MP + MS, NIN = 2048, FF = 4096, NL = 2;
constexpr int NMODROW = 256, NMOD = 6144, MODLD = NL * NMOD;
constexpr float LN_EPS = 1e-5f;
constexpr float DN_ALPHA = 1.41421356237309515f;
constexpr size_t O_YP = 0, O_YS = (size_t)MP * D, O_CP = O_YS + (size_t)MS * D, O_PP = O_CP + (size_t)NL * BP * 2 * 256, O_CS = O_PP + (size_t)NL * BP * 15 * 256,
                 O_PS = O_CS + (size_t)NL * BS * 2 * 256, O_VS = O_PS + (size_t)NL * BS * 15 * 256, O_END = O_VS + (size_t)NL * BS * TS * 512;
constexpr size_t MiB = 1u << 20;
constexpr size_t WS_CTL = 0, CTL_ZERO_BYTES = 1 * MiB;
constexpr size_t WS_WIN = 2 * MiB, WS_WOUT = 10 * MiB, WS_WUP = 14 * MiB, WS_WDN = 30 * MiB;
constexpr size_t WS_MOD = 46 * MiB, WS_X = 58 * MiB, WS_HA = 60 * MiB, WS_BIG = 94 * MiB;
constexpr size_t WS_PROJ = WS_BIG, WS_MIX = WS_BIG + 68 * MiB, WS_HID = WS_BIG;
constexpr size_t WS_WADA = WS_BIG, WS_AC = WS_BIG + 24 * MiB;
constexpr size_t WS_END = WS_BIG + 136 * MiB;
static_assert(WS_END <= 256 * MiB, "d_ws map");
constexpr size_t WS_WTRIL = WS_X, WS_PWT = WS_X + 512 * 1024;
constexpr int CW_TMO = 0, CW_CODE = 1, CW_BAR = 4096;

constexpr int LDSCTL_OFF = 0, LDSCTL_BYTES = 512, MISC_OFF = LDSCTL_OFF + 320, RING_OFF = 512, RING_BYTES = 131072;
constexpr int VN_RS = 544, DT_RS = 528, MIX_LDS = 128 * VN_RS + 128 * DT_RS;
constexpr int LDS_BYTES = RING_OFF + (MIX_LDS > RING_BYTES ? MIX_LDS : RING_BYTES) + 512;
static_assert(LDS_BYTES <= 160 * 1024 && LDS_BYTES > 80 * 1024 && RING_OFF % 16 == 0, "LDS map");

#define GAS __attribute__((address_space(1)))
#define LAS __attribute__((address_space(3)))
typedef unsigned short bf16;
typedef unsigned v4u __attribute__((ext_vector_type(4)));
typedef unsigned v2u __attribute__((ext_vector_type(2)));
typedef float f32x4 __attribute__((ext_vector_type(4)));
typedef GAS unsigned gu32;
#define RLX_AGENT __ATOMIC_RELAXED, __HIP_MEMORY_SCOPE_AGENT
#define LDS_WAIT() asm volatile("s_waitcnt lgkmcnt(0)" ::: "memory")
#define VM_WAIT() asm volatile("s_waitcnt vmcnt(0)" ::: "memory")
__device__ __forceinline__ unsigned f2bf(float f) { unsigned u = __builtin_bit_cast(unsigned, f); return (u + 0x7fffu + ((u >> 16) & 1u)) >> 16; }
__device__ __forceinline__ unsigned pk2(float lo, float hi) { return pg8::cvt_pk_bf16(lo, hi); }
__device__ __forceinline__ float bflo(unsigned w) { return __builtin_bit_cast(float, w << 16); }
__device__ __forceinline__ float bfhi(unsigned w) { return __builtin_bit_cast(float, w & 0xffff0000u); }
__device__ __forceinline__ float bf1(bf16 h) { return __builtin_bit_cast(float, (unsigned)h << 16); }

#define XB_TMO      128
#define XB_XCNT(j)  (256  + 64 * (j))
#define XB_XSUB(j)  (1280 + 64 * (j))
#define XB_XGEN(j)  (2304 + 64 * (j))
#define XB_TOP      3328
#define XB_TOPGEN   3392
#define XCD_BAR_WORDS 3456
#define XB_SPIN_CAP (1u << 18)

__device__ __forceinline__ unsigned xb_ld(unsigned* p)              { return __hip_atomic_load(p, __ATOMIC_RELAXED, __HIP_MEMORY_SCOPE_AGENT); }
__device__ __forceinline__ unsigned xb_add(unsigned* p, unsigned v) { return __hip_atomic_fetch_add(p, v, __ATOMIC_RELAXED, __HIP_MEMORY_SCOPE_AGENT); }
__device__ __forceinline__ unsigned xb_xcc_id() { return (unsigned)__builtin_amdgcn_s_getreg((3 << 11) | 20) & 0xFu; }
#define XB_SPIN(cond, bar) do { unsigned _sp = 0; while (cond) { __builtin_amdgcn_s_sleep(1); \
    if ((++_sp & 255u) == 0u) { if (xb_ld(&(bar)[XB_TMO])) break; if (_sp > XB_SPIN_CAP) { atomicAdd(&(bar)[XB_TMO], 1u); break; } } } } while (0)

struct XcdBarrier {
    unsigned* bar; unsigned x;
    volatile LAS unsigned* st;
};

__device__ __forceinline__ XcdBarrier xcd_barrier_post(unsigned* bar, volatile LAS unsigned* st) {
    XcdBarrier b; b.bar = bar; b.x = xb_xcc_id(); b.st = st;
    if (threadIdx.x == 0) (void)xb_add(&bar[XB_XCNT(b.x)], 1u);
    return b;
}
__device__ __forceinline__ void xcd_barrier_complete(unsigned* bar, unsigned x, unsigned& nloc, unsigned& nx) {
    const unsigned G = gridDim.x * gridDim.y * gridDim.z;
    unsigned sum, cnt, mine, sp = 0u;
    for (;;) {
        sum = 0u; cnt = 0u; mine = 0u;
#pragma unroll
        for (unsigned j = 0; j < 16; ++j) { const unsigned c = xb_ld(&bar[XB_XCNT(j)]); sum += c; cnt += (c > 0u) ? 1u : 0u; mine = (j == x) ? c : mine; }
        if (sum == G) break;
        __builtin_amdgcn_s_sleep(1);
        if ((++sp & 255u) == 0u) { if (xb_ld(&bar[XB_TMO])) break; if (sp > XB_SPIN_CAP) { atomicAdd(&bar[XB_TMO], 1u); break; } }
    }
    nloc = mine > 0u ? mine : 1u; nx = cnt > 0u ? cnt : 1u;
}

__device__ __forceinline__ void xcd_barrier(const XcdBarrier& b) {
    asm volatile("s_waitcnt vmcnt(0)" ::: "memory");
    __syncthreads();
    if (threadIdx.x == 0) {
        unsigned* bar = b.bar;
        __builtin_amdgcn_s_waitcnt(0);
        unsigned nloc = b.st[0], nx = b.st[1];
        if (nloc == 0u) { xcd_barrier_complete(bar, b.x, nloc, nx); b.st[0] = nloc; b.st[1] = nx; }
        const unsigned old = xb_add(&bar[XB_XSUB(b.x)], 1u);
        const unsigned gen = old / nloc;
        if (old + 1u == (gen + 1u) * nloc) {
            __builtin_amdgcn_fence(__ATOMIC_RELEASE, "agent");
            asm volatile("s_waitcnt vmcnt(0)" ::: "memory");
            const unsigned og = xb_add(&bar[XB_TOP], 1u);
            const unsigned tg = og / nx;
            if (og + 1u == (tg + 1u) * nx) xb_add(&bar[XB_TOPGEN], 1u);
            else XB_SPIN(xb_ld(&bar[XB_TOPGEN]) == tg, bar);
            __builtin_amdgcn_fence(__ATOMIC_ACQUIRE, "agent");
            xb_add(&bar[XB_XGEN(b.x)], 1u);
            asm volatile("s_waitcnt vmcnt(0)" ::: "memory");
        } else {
            XB_SPIN(xb_ld(&bar[XB_XGEN(b.x)]) == gen, bar);
            __builtin_amdgcn_fence(__ATOMIC_ACQUIRE, "agent");
            asm volatile("s_waitcnt vmcnt(0)" ::: "memory");
        }
    }
    __syncthreads();
}


struct Args { const float* in[23]; float* out; unsigned char* ws; int ph_lo, ph_hi; };
struct Frame {
    LAS unsigned char* lds; volatile LAS unsigned* MISC; gu32* ctl;
    int tid, lane, wave, vcu, G;
};
__device__ __forceinline__ float wave_sum(float v) {
#pragma unroll
    for (int o = 1; o < 64; o <<= 1) v += __shfl_xor(v, o);
    return v;
}
__device__ __forceinline__ int mod_row(int r) { return r < MP ? (r >> 11) : BP + ((r - MP) >> 3); }

__device__ __forceinline__ void p0_transpose_item(const float* W, int K, int N, bf16* WT, int row_off, LAS float* scr, int item, int lane) {
    const int nblk = N / 32, kb = item / nblk, nb = item % nblk, k0 = 64 * kb, n0 = 32 * nb;
#pragma unroll 8
    for (int i = 0; i < 32; ++i) { const int kk = 2 * i + (lane >> 5); scr[kk * 33 + (lane & 31)] = W[(size_t)(k0 + kk) * N + n0 + (lane & 31)]; }
    LDS_WAIT(); asm volatile("" ::: "memory");
    const int c = lane & 7;
#pragma unroll
    for (int j = 0; j < 4; ++j) { const int n = (lane >> 3) + 8 * j; const LAS float* s = scr + (8 * c) * 33 + n;
        v4u o; o.x = pk2(s[0 * 33], s[1 * 33]); o.y = pk2(s[2 * 33], s[3 * 33]); o.z = pk2(s[4 * 33], s[5 * 33]); o.w = pk2(s[6 * 33], s[7 * 33]);
        *(GAS v4u*)(WT + (size_t)(row_off + n0 + n) * K + k0 + 8 * c) = o; }
    LDS_WAIT(); asm volatile("" ::: "memory");
}

__device__ __forceinline__ void p0_prologue(Frame& F, const Args& a) {
    LAS float* scr = (LAS float*)(F.lds + RING_OFF + F.wave * 16384);
    const int gw = F.vcu * NWAVES + F.wave, NGW = F.G * NWAVES;
    unsigned char* ws = a.ws;
    constexpr int I_IN = (D / 64) * (NIN / 32), I_OUT = (D / 64) * (D / 32), I_UP = (D / 64) * (FF / 32), I_DN = (FF / 64) * (D / 32), I_ADA = (D / 64) * (NMOD / 32);
    constexpr int PER_L = I_IN + I_OUT + I_UP + I_DN + I_ADA, NITEMS = NL * PER_L;
    for (int it = gw; it < NITEMS; it += NGW) {
        const int l = it / PER_L; int r = it % PER_L;
        if (r < I_ADA) { p0_transpose_item(a.in[6] + (size_t)l * D * NMOD, D, NMOD, (bf16*)(ws + WS_WADA), l * NMOD, scr, r, F.lane); continue; } r -= I_ADA;
        if (r < I_IN) { p0_transpose_item(a.in[8] + (size_t)l * D * NIN, D, NIN, (bf16*)(ws + WS_WIN) + (size_t)l * NIN * D, 0, scr, r, F.lane); continue; } r -= I_IN;
        if (r < I_OUT) { p0_transpose_item(a.in[16] + (size_t)l * D * D, D, D, (bf16*)(ws + WS_WOUT) + (size_t)l * D * D, 0, scr, r, F.lane); continue; } r -= I_OUT;
        if (r < I_UP) { p0_transpose_item(a.in[19] + (size_t)l * D * FF, D, FF, (bf16*)(ws + WS_WUP) + (size_t)l * FF * D, 0, scr, r, F.lane); continue; } r -= I_UP;
        p0_transpose_item(a.in[20] + (size_t)l * FF * D, FF, D, (bf16*)(ws + WS_WDN) + (size_t)l * D * FF, 0, scr, r, F.lane);
    }
    {
        const int gt = F.vcu * (NWAVES * 64) + F.tid, NGT = F.G * NWAVES * 64;
        bf16* WT = (bf16*)(ws + WS_WTRIL); bf16* PWT = (bf16*)(ws + WS_PWT);
        for (int e = gt; e < NL * 8 * 128 * 128; e += NGT) { const int j = e & 127, i = (e >> 7) & 127; WT[e] = (bf16)(j <= i ? f2bf(a.in[12][e]) : 0u); }
        for (int e = gt; e < NL * 4 * 64 * 64; e += NGT) { const int c = e & 63, dd = (e >> 6) & 63, lg = e >> 12; PWT[e] = (bf16)f2bf(a.in[14][((size_t)lg * 64 + c) * 64 + dd]); }
    }
    bf16* AC = (bf16*)(ws + WS_AC);
    for (int m = gw; m < NMODROW; m += NGW) {
        GAS unsigned long long* o8 = (GAS unsigned long long*)(AC + (size_t)m * D) + F.lane;
        if (m < BP + BS) { const float* crow = m < BP ? a.in[2] + (size_t)m * D : a.in[3] + (size_t)(m - BP) * D;
            const GAS f32x4* xr = (const GAS f32x4*)crow + F.lane;
#pragma unroll
            for (int j = 0; j < 4; ++j) { f32x4 v = xr[64 * j];
#pragma unroll
                for (int e = 0; e < 4; ++e) v[e] = v[e] / (1.0f + __expf(-v[e]));
                o8[64 * j] = (unsigned long long)pk2(v.x, v.y) | ((unsigned long long)pk2(v.z, v.w) << 32); }
        } else {
#pragma unroll
            for (int j = 0; j < 4; ++j) o8[64 * j] = 0ull; }
    }
}

__device__ __forceinline__ void modulate_rows(Frame& F, const float* xp, const float* xs, const float* mod_sh, const float* mod_sc, bf16* hb) {
    const int gw = F.vcu * NWAVES + F.wave, NGW = F.G * NWAVES;
    for (int r = gw; r < M; r += NGW) {
        const float* xrow = r < MP ? xp + (size_t)r * D : xs + (size_t)(r - MP) * D; const int mr = mod_row(r);
        const GAS f32x4* xr = (const GAS f32x4*)xrow + F.lane; const GAS f32x4* sh = (const GAS f32x4*)(mod_sh + (size_t)mr * MODLD) + F.lane; const GAS f32x4* sc = (const GAS f32x4*)(mod_sc + (size_t)mr * MODLD) + F.lane;
        GAS unsigned long long* o8 = (GAS unsigned long long*)(hb + (size_t)r * D) + F.lane;
#pragma unroll
        for (int j = 0; j < 4; ++j) { const f32x4 v = xr[64 * j], a = sh[64 * j], b = sc[64 * j]; const f32x4 h = v * (b + 1.0f) + a;
            o8[64 * j] = (unsigned long long)pk2(h.x, h.y) | ((unsigned long long)pk2(h.z, h.w) << 32); }
    }
}
__device__ __forceinline__ void ln_rows(Frame& F, float* x, const float* g, const float* b, const float* mod_sh, const float* mod_sc, bf16* hb) {
    const int gw = F.vcu * NWAVES + F.wave, NGW = F.G * NWAVES;
    for (int r = gw; r < M; r += NGW) {
        GAS f32x4* xr = (GAS f32x4*)(x + (size_t)r * D) + F.lane; const int mr = mod_row(r);
        f32x4 v[4]; float s = 0.f;
#pragma unroll
        for (int j = 0; j < 4; ++j) { v[j] = xr[64 * j]; s += (v[j].x + v[j].y) + (v[j].z + v[j].w); }
        const float mean = wave_sum(s) * (1.f / D); float s2 = 0.f;
#pragma unroll
        for (int j = 0; j < 4; ++j) { v[j] = v[j] - mean; s2 += (v[j].x * v[j].x + v[j].y * v[j].y) + (v[j].z * v[j].z + v[j].w * v[j].w); }
        const float rstd = 1.f / sqrtf(wave_sum(s2) * (1.f / D) + LN_EPS);
#pragma unroll
        for (int j = 0; j < 4; ++j) { const f32x4 gg = ((const GAS f32x4*)g)[F.lane + 64 * j], bb = ((const GAS f32x4*)b)[F.lane + 64 * j]; v[j] = v[j] * rstd * gg + bb; xr[64 * j] = v[j]; }
        if (hb) { const GAS f32x4* sh = (const GAS f32x4*)(mod_sh + (size_t)mr * MODLD) + F.lane; const GAS f32x4* sc = (const GAS f32x4*)(mod_sc + (size_t)mr * MODLD) + F.lane;
            GAS unsigned long long* o8 = (GAS unsigned long long*)(hb + (size_t)r * D) + F.lane;
#pragma unroll
            for (int j = 0; j < 4; ++j) { const f32x4 h = v[j] * (sc[64 * j] + 1.0f) + sh[64 * j]; o8[64 * j] = (unsigned long long)pk2(h.x, h.y) | ((unsigned long long)pk2(h.z, h.w) << 32); } }
    }
}

__device__ __forceinline__ void unpack4(v2u w, float (&f)[4]) { f[0] = bflo(w.x); f[1] = bfhi(w.x); f[2] = bflo(w.y); f[3] = bfhi(w.y); }

__device__ __forceinline__ void conv_phase(Frame& F, const Args& a, int l, const bf16* proj, bf16* mix, int tg_lo, int tg_hi) {
    const int gt = F.vcu * (NWAVES * 64) + F.tid, NGT = F.G * NWAVES * 64;
    const float* cw = a.in[9] + (size_t)l * 3 * 256;
    for (int it = gt; it < (tg_hi - tg_lo) * 64; it += NGT) {
        const int cg = it & 63, tg = tg_lo + (it >> 6), r0 = tg * 8, c = cg * 4; const bool samp = r0 >= MP;
        const int t0 = samp ? 0 : (r0 & (TP - 1)); const int sb = samp ? (r0 - MP) >> 3 : (r0 >> 11);
        float zm2[4] = {0.f, 0.f, 0.f, 0.f}, zm1[4] = {0.f, 0.f, 0.f, 0.f};
        if (samp) { const float* st = a.in[4] + ((size_t)(l * BS + sb) * 2) * 256 + c; const f32x4 s0 = *(const f32x4*)st, s1 = *(const f32x4*)(st + 256);
#pragma unroll
            for (int e = 0; e < 4; ++e) { zm2[e] = s0[e]; zm1[e] = s1[e]; } }
        else if (t0 != 0) { float p[4], q[4];
            unpack4(*(const v2u*)(proj + (size_t)(r0 - 2) * NIN + 256 + c), p); unpack4(*(const v2u*)(proj + (size_t)(r0 - 2) * NIN + 512 + c), q);
#pragma unroll
            for (int e = 0; e < 4; ++e) zm2[e] = p[e] * q[e];
            unpack4(*(const v2u*)(proj + (size_t)(r0 - 1) * NIN + 256 + c), p); unpack4(*(const v2u*)(proj + (size_t)(r0 - 1) * NIN + 512 + c), q);
#pragma unroll
            for (int e = 0; e < 4; ++e) zm1[e] = p[e] * q[e]; }
        const f32x4 w0 = *(const f32x4*)(cw + c), w1 = *(const f32x4*)(cw + 256 + c), w2 = *(const f32x4*)(cw + 512 + c);
        const bool last_p = (!samp) && (t0 + 8 == TP);
#pragma unroll
        for (int tt = 0; tt < 8; ++tt) { const size_t ro = (size_t)(r0 + tt) * NIN; float ab[4], ac[4], ax[4], z[4], y[4];
            unpack4(*(const v2u*)(proj + ro + c), ab); unpack4(*(const v2u*)(proj + ro + 256 + c), ac); unpack4(*(const v2u*)(proj + ro + 512 + c), ax);
#pragma unroll
            for (int e = 0; e < 4; ++e) { z[e] = ac[e] * ax[e]; y[e] = ab[e] * (zm2[e] * w0[e] + zm1[e] * w1[e] + z[e] * w2[e]); zm2[e] = zm1[e]; zm1[e] = z[e]; }
            v2u o; o.x = pk2(y[0], y[1]); o.y = pk2(y[2], y[3]); *(v2u*)(mix + (size_t)(r0 + tt) * D + c) = o;
            if (tt >= 6) { const f32x4 zz = {z[0], z[1], z[2], z[3]};
                if (samp) *(f32x4*)(a.out + O_CS + ((size_t)(l * BS + sb) * 2 + (tt - 6)) * 256 + c) = zz;
                else if (last_p) *(f32x4*)(a.out + O_CP + ((size_t)(l * BP + sb) * 2 + (tt - 6)) * 256 + c) = zz; }
        }
    }
}

template <int W> __device__ __forceinline__ void pool_item(Frame& F, const Args& a, int l, const bf16* proj, bf16* mix, int tg, int g) {
    const int lane = F.lane, ch = g * 64 + lane, r0 = tg * 8; const bool samp = r0 >= MP;
    const int t0 = samp ? 0 : (r0 & (TP - 1)); const int sb = samp ? (r0 - MP) >> 3 : (r0 >> 11);
    float e[W - 1 + 8];
#pragma unroll
    for (int k = -(W - 1); k < 8; ++k) { float v;
        if (k >= 0) v = bf1(proj[(size_t)(r0 + k) * NIN + 1792 + ch]);
        else if (samp) v = a.in[5][((size_t)(l * BS + sb) * 15 + (15 + k)) * 256 + ch];
        else v = (t0 + k >= 0) ? bf1(proj[(size_t)(r0 + k) * NIN + 1792 + ch]) : 0.f;
        e[k + W - 1] = v; }
    float d[8];
#pragma unroll
    for (int tt = 0; tt < 8; ++tt) { float s = 0.f;
#pragma unroll
        for (int i = 0; i < W; ++i) s += e[tt - i + W - 1];
        const int cnt = samp ? W : ((t0 + tt + 1) < W ? (t0 + tt + 1) : W);
        d[tt] = s / (float)cnt - e[tt + W - 1]; }
    float acc[8] = {0.f, 0.f, 0.f, 0.f, 0.f, 0.f, 0.f, 0.f};
    const float* pw = a.in[14] + ((size_t)(l * 4 + g) * 64) * 64 + lane;
    for (int c = 0; c < 64; ++c) { const float w = pw[(size_t)c * 64];
#pragma unroll
        for (int tt = 0; tt < 8; ++tt) acc[tt] += __builtin_bit_cast(float, __builtin_amdgcn_readlane(__builtin_bit_cast(int, d[tt]), c)) * w; }
    const float ps = a.in[15][l * 256 + ch];
#pragma unroll
    for (int tt = 0; tt < 8; ++tt) mix[(size_t)(r0 + tt) * D + 768 + ch] = (bf16)f2bf(acc[tt] * ps);
    if (samp) { float* o = a.out + O_PS + ((size_t)(l * BS + sb) * 15) * 256 + ch;
#pragma unroll
        for (int j = 0; j < 7; ++j) o[(size_t)j * 256] = a.in[5][((size_t)(l * BS + sb) * 15 + (8 + j)) * 256 + ch];
#pragma unroll
        for (int j = 7; j < 15; ++j) o[(size_t)j * 256] = e[(j - 7) + W - 1];
    } else if (t0 + 8 > TP - 15) { float* o = a.out + O_PP + ((size_t)(l * BP + sb) * 15) * 256 + ch;
#pragma unroll
        for (int tt = 0; tt < 8; ++tt) { const int j = t0 + tt - (TP - 15); if (j >= 0) o[(size_t)j * 256] = e[tt + W - 1]; } }
}
__device__ __forceinline__ void pool_phase(Frame& F, const Args& a, int l, const bf16* proj, bf16* mix, int tg_lo, int tg_hi) {
    const int gw = F.vcu * NWAVES + F.wave, NGW = F.G * NWAVES;
    for (int it = gw; it < (tg_hi - tg_lo) * 4; it += NGW) { const int g = it & 3, tg = tg_lo + (it >> 2);
        if (g == 0) pool_item<2>(F, a, l, proj, mix, tg, 0); else if (g == 1) pool_item<4>(F, a, l, proj, mix, tg, 1);
        else if (g == 2) pool_item<8>(F, a, l, proj, mix, tg, 2); else pool_item<16>(F, a, l, proj, mix, tg, 3); }
}

__device__ __forceinline__ void sgu_phase(Frame& F, const Args& a, int l, const bf16* proj, bf16* mix) {
    LAS float* VN = (LAS float*)(F.lds + RING_OFF);
    const float* sg = a.in[10] + l * 512; const float* sbv = a.in[11] + l * 512;
    for (int unit = F.vcu; unit < (M / 128) * 2; unit += F.G) {
        const int hh = unit & 1, ck = unit >> 1, r0 = ck * 128; const bool samp = r0 >= MP;
        for (int i = F.wave * 16; i < F.wave * 16 + 16; ++i) { const int r = r0 + i;
            const v4u raw = *(const v4u*)(proj + (size_t)r * NIN + 1280 + 8 * F.lane);
            float v[8] = {bflo(raw.x), bfhi(raw.x), bflo(raw.y), bfhi(raw.y), bflo(raw.z), bfhi(raw.z), bflo(raw.w), bfhi(raw.w)}; float s = 0.f;
#pragma unroll
            for (int k = 0; k < 8; ++k) s += v[k];
            const float mean = wave_sum(s) * (1.f / 512.f); float s2 = 0.f;
#pragma unroll
            for (int k = 0; k < 8; ++k) { v[k] -= mean; s2 += v[k] * v[k]; }
            const float rstd = 1.f / sqrtf(wave_sum(s2) * (1.f / 512.f) + LN_EPS);
            if ((F.lane >> 5) == hh) { const f32x4 g0 = *(const f32x4*)(sg + 8 * F.lane), g1 = *(const f32x4*)(sg + 8 * F.lane + 4), b0 = *(const f32x4*)(sbv + 8 * F.lane), b1 = *(const f32x4*)(sbv + 8 * F.lane + 4);
                f32x4 o0 = {v[0], v[1], v[2], v[3]}, o1 = {v[4], v[5], v[6], v[7]}; o0 = o0 * rstd * g0 + b0; o1 = o1 * rstd * g1 + b1;
                LAS f32x4* dst = (LAS f32x4*)(VN + i * 256 + 8 * (F.lane & 31)); dst[0] = o0; dst[1] = o1;
                if (samp) { float* vo = a.out + O_VS + ((size_t)l * MS + (r - MP)) * 512 + 8 * F.lane; *(f32x4*)vo = o0; *(f32x4*)(vo + 4) = o1; } }
        }
        LDS_WAIT(); __syncthreads();
        for (int p = F.wave; p < 4 * 128; p += NWAVES) { const int hl = p & 3, i = p >> 2, h = hh * 4 + hl, j0 = samp ? (i & ~7) : 0;
            const float* wrow = a.in[12] + ((size_t)(l * 8 + h) * 128 + (i - j0)) * 128; float acc = 0.f;
            for (int j = j0; j <= i; ++j) acc += wrow[j - j0] * VN[j * 256 + hl * 64 + F.lane];
            const float s = acc + a.in[13][(l * 8 + h) * 128 + (i - j0)];
            const float u = bf1(proj[(size_t)(r0 + i) * NIN + 768 + h * 64 + F.lane]);
            mix[(size_t)(r0 + i) * D + 256 + h * 64 + F.lane] = (bf16)f2bf(u * s); }
        LDS_WAIT(); __syncthreads();
    }
}

typedef short bf16x8 __attribute__((ext_vector_type(8)));
typedef short s16x4 __attribute__((ext_vector_type(4)));
__device__ __forceinline__ s16x4 vtr(const LAS unsigned char* p) { return __builtin_bit_cast(s16x4, __builtin_amdgcn_ds_read_tr16_b64_v4i16((LAS s16x4*)p)); }

__device__ __forceinline__ void sgu_sample_item(Frame& F, const Args& a, int l, const bf16* proj, bf16* mix, int b) {
    const int lane = F.lane, h = lane >> 3; const size_t rb = (size_t)MP + 8 * b;
    const f32x4 g0 = *(const f32x4*)(a.in[10] + l * 512 + 8 * lane), g1 = *(const f32x4*)(a.in[10] + l * 512 + 8 * lane + 4), b0 = *(const f32x4*)(a.in[11] + l * 512 + 8 * lane), b1 = *(const f32x4*)(a.in[11] + l * 512 + 8 * lane + 4);
    float vn[8][8];
#pragma unroll
    for (int t = 0; t < 8; ++t) { const v4u raw = *(const v4u*)(proj + (rb + t) * NIN + 1280 + 8 * lane);
        float v[8] = {bflo(raw.x), bfhi(raw.x), bflo(raw.y), bfhi(raw.y), bflo(raw.z), bfhi(raw.z), bflo(raw.w), bfhi(raw.w)}; float s = 0.f;
#pragma unroll
        for (int k = 0; k < 8; ++k) s += v[k];
        const float mean = wave_sum(s) * (1.f / 512.f); float s2 = 0.f;
#pragma unroll
        for (int k = 0; k < 8; ++k) { v[k] -= mean; s2 += v[k] * v[k]; }
        const float rstd = 1.f / sqrtf(wave_sum(s2) * (1.f / 512.f) + LN_EPS);
        f32x4 o0 = {v[0], v[1], v[2], v[3]}, o1 = {v[4], v[5], v[6], v[7]}; o0 = o0 * rstd * g0 + b0; o1 = o1 * rstd * g1 + b1;
        float* vo = a.out + O_VS + ((size_t)l * MS + 8 * b + t) * 512 + 8 * lane; *(f32x4*)vo = o0; *(f32x4*)(vo + 4) = o1;
#pragma unroll
        for (int k = 0; k < 4; ++k) { vn[t][k] = o0[k]; vn[t][4 + k] = o1[k]; } }
    const float* wh = a.in[12] + (size_t)(l * 8 + h) * 128 * 128; const float* bh = a.in[13] + (l * 8 + h) * 128;
#pragma unroll
    for (int i = 0; i < 8; ++i) { float s[8]; const float bs = bh[i];
#pragma unroll
        for (int k = 0; k < 8; ++k) s[k] = bs;
#pragma unroll
        for (int j = 0; j <= i; ++j) { const float w = wh[i * 128 + j];
#pragma unroll
            for (int k = 0; k < 8; ++k) s[k] += w * vn[j][k]; }
        const v4u uw = *(const v4u*)(proj + (rb + i) * NIN + 768 + 8 * lane);
        v4u o; o.x = pk2(bflo(uw.x) * s[0], bfhi(uw.x) * s[1]); o.y = pk2(bflo(uw.y) * s[2], bfhi(uw.y) * s[3]); o.z = pk2(bflo(uw.z) * s[4], bfhi(uw.z) * s[5]); o.w = pk2(bflo(uw.w) * s[6], bfhi(uw.w) * s[7]);
        *(v4u*)(mix + (rb + i) * D + 256 + 8 * lane) = o; }
}

__device__ __forceinline__ void mixer_prompt_unit(Frame& F, const Args& a, int l, const bf16* proj, bf16* mix, const bf16* WT, const bf16* PWT, int unit) {
    const int hh = unit & 1, ck = unit >> 1, r0 = ck * 128, t0 = r0 & (TP - 1), bb = r0 >> 11, lane = F.lane, w = F.wave, tid = F.tid;
    LAS unsigned char* VN = F.lds + RING_OFF; LAS unsigned char* DT = VN + 128 * VN_RS;
    {
        const f32x4 g0 = *(const f32x4*)(a.in[10] + l * 512 + 8 * lane), g1 = *(const f32x4*)(a.in[10] + l * 512 + 8 * lane + 4), b0 = *(const f32x4*)(a.in[11] + l * 512 + 8 * lane), b1 = *(const f32x4*)(a.in[11] + l * 512 + 8 * lane + 4);
        v4u raw[16];
#pragma unroll
        for (int i = 0; i < 16; ++i) raw[i] = *(const v4u*)(proj + (size_t)(r0 + w * 16 + i) * NIN + 1280 + 8 * lane);
#pragma unroll
        for (int i = 0; i < 16; ++i) {
            float v[8] = {bflo(raw[i].x), bfhi(raw[i].x), bflo(raw[i].y), bfhi(raw[i].y), bflo(raw[i].z), bfhi(raw[i].z), bflo(raw[i].w), bfhi(raw[i].w)}; float s = 0.f;
#pragma unroll
            for (int k = 0; k < 8; ++k) s += v[k];
            const float mean = wave_sum(s) * (1.f / 512.f); float s2 = 0.f;
#pragma unroll
            for (int k = 0; k < 8; ++k) { v[k] -= mean; s2 += v[k] * v[k]; }
            const float rstd = 1.f / sqrtf(wave_sum(s2) * (1.f / 512.f) + LN_EPS);
            if ((lane >> 5) == hh) { f32x4 o0 = {v[0], v[1], v[2], v[3]}, o1 = {v[4], v[5], v[6], v[7]}; o0 = o0 * rstd * g0 + b0; o1 = o1 * rstd * g1 + b1;
                v4u o; o.x = pk2(o0[0], o0[1]); o.y = pk2(o0[2], o0[3]); o.z = pk2(o1[0], o1[1]); o.w = pk2(o1[2], o1[3]);
                *(LAS v4u*)(VN + (w * 16 + i) * VN_RS + 16 * (lane & 31)) = o; }
        }
    }
    const int cg = tid & 63, c = 4 * cg;
    if (hh == 0) {
        const float* cw = a.in[9] + (size_t)l * 3 * 256;
        const f32x4 w0 = *(const f32x4*)(cw + c), w1 = *(const f32x4*)(cw + 256 + c), w2 = *(const f32x4*)(cw + 512 + c);
        const int rs = r0 + 16 * w; float zm2[4] = {0.f, 0.f, 0.f, 0.f}, zm1[4] = {0.f, 0.f, 0.f, 0.f};
        if (t0 + 16 * w != 0) { float p[4], q[4];
            unpack4(*(const v2u*)(proj + (size_t)(rs - 2) * NIN + 256 + c), p); unpack4(*(const v2u*)(proj + (size_t)(rs - 2) * NIN + 512 + c), q);
#pragma unroll
            for (int e = 0; e < 4; ++e) zm2[e] = p[e] * q[e];
            unpack4(*(const v2u*)(proj + (size_t)(rs - 1) * NIN + 256 + c), p); unpack4(*(const v2u*)(proj + (size_t)(rs - 1) * NIN + 512 + c), q);
#pragma unroll
            for (int e = 0; e < 4; ++e) zm1[e] = p[e] * q[e]; }
        const bool lastrows = (t0 + 128 == TP) && (w == 7);
#pragma unroll
        for (int tt = 0; tt < 16; ++tt) { const size_t ro = (size_t)(rs + tt) * NIN; float ab[4], ac[4], ax[4], z[4], y[4];
            unpack4(*(const v2u*)(proj + ro + c), ab); unpack4(*(const v2u*)(proj + ro + 256 + c), ac); unpack4(*(const v2u*)(proj + ro + 512 + c), ax);
#pragma unroll
            for (int e = 0; e < 4; ++e) { z[e] = ac[e] * ax[e]; y[e] = ab[e] * (zm2[e] * w0[e] + zm1[e] * w1[e] + z[e] * w2[e]); zm2[e] = zm1[e]; zm1[e] = z[e]; }
            v2u o; o.x = pk2(y[0], y[1]); o.y = pk2(y[2], y[3]); *(v2u*)(mix + (size_t)(rs + tt) * D + c) = o;
            if (tt >= 14 && lastrows) { const f32x4 zz = {z[0], z[1], z[2], z[3]}; *(f32x4*)(a.out + O_CP + ((size_t)(l * BP + bb) * 2 + (tt - 14)) * 256 + c) = zz; }
        }
    } else {
        const int wl = 2 << (cg >> 4);
#pragma unroll 1
        for (int sp = 0; sp < 2; ++sp) { const int tl0 = 8 * (2 * w + sp), rs = r0 + tl0;
            float cs[24][4];
            float ev[8][4];
#pragma unroll
            for (int e = 0; e < 4; ++e) cs[0][e] = 0.f;
#pragma unroll
            for (int k = -15; k < 8; ++k) { float p[4] = {0.f, 0.f, 0.f, 0.f};
                if (k >= 0 || t0 + tl0 + k >= 0) unpack4(*(const v2u*)(proj + (size_t)(rs + k) * NIN + 1792 + c), p);
#pragma unroll
                for (int e = 0; e < 4; ++e) { cs[k + 16][e] = cs[k + 15][e] + p[e]; if (k >= 0) ev[k][e] = p[e]; } }
#pragma unroll
            for (int tt = 0; tt < 8; ++tt) { const int tp = t0 + tl0 + tt + 1; const float cnt = (float)(tp < wl ? tp : wl); float dv[4];
#pragma unroll
                for (int e = 0; e < 4; ++e) { const float lo = wl == 2 ? cs[tt + 14][e] : wl == 4 ? cs[tt + 12][e] : wl == 8 ? cs[tt + 8][e] : cs[tt][e];
                    dv[e] = (cs[tt + 16][e] - lo) / cnt - ev[tt][e]; }
                v2u o; o.x = pk2(dv[0], dv[1]); o.y = pk2(dv[2], dv[3]); *(LAS v2u*)(DT + (tl0 + tt) * DT_RS + 2 * c) = o;
                if (t0 + 128 == TP && tl0 + tt >= 113) { const f32x4 pv = {ev[tt][0], ev[tt][1], ev[tt][2], ev[tt][3]}; *(f32x4*)(a.out + O_PP + ((size_t)(l * BP + bb) * 15 + (tl0 + tt - 113)) * 256 + c) = pv; }
            }
        }
    }
    LDS_WAIT(); __syncthreads();
    const int g = lane >> 4, i16 = lane & 15;
    {
        const int hl = w >> 1, dh = w & 1, h = hh * 4 + hl, q = i16 >> 2, p = i16 & 3;
        f32x4 acc[2][8];
#pragma unroll
        for (int dt = 0; dt < 2; ++dt)
#pragma unroll
            for (int it = 0; it < 8; ++it) acc[dt][it] = (f32x4){0.f, 0.f, 0.f, 0.f};
        const LAS unsigned char* vbase = VN + (8 * g + q) * VN_RS + (hl * 64 + dh * 32 + 4 * p) * 2;
        const bf16* wbase = WT + ((size_t)h * 128 + i16) * 128 + 8 * g;
#pragma unroll
        for (int ks = 0; ks < 4; ++ks) { bf16x8 Af[2];
#pragma unroll
            for (int dt = 0; dt < 2; ++dt) { const s16x4 lo = vtr(vbase + (32 * ks) * VN_RS + dt * 32), hi = vtr(vbase + (32 * ks + 4) * VN_RS + dt * 32);
                Af[dt] = (bf16x8){lo[0], lo[1], lo[2], lo[3], hi[0], hi[1], hi[2], hi[3]}; }
#pragma unroll
            for (int it = 2 * ks; it < 8; ++it) { const bf16x8 Bf = *(const bf16x8*)(wbase + (size_t)it * 16 * 128 + 32 * ks);
#pragma unroll
                for (int dt = 0; dt < 2; ++dt) acc[dt][it] = __builtin_amdgcn_mfma_f32_16x16x32_bf16(Af[dt], Bf, acc[dt][it], 0, 0, 0); } }
        const float* bsr = a.in[13] + (l * 8 + h) * 128;
#pragma unroll
        for (int it = 0; it < 8; ++it) { const int i = it * 16 + i16; const float bs = bsr[i]; const size_t ro = (size_t)(r0 + i);
#pragma unroll
            for (int dt = 0; dt < 2; ++dt) { const int ch = h * 64 + dh * 32 + dt * 16 + 4 * g; float u[4]; unpack4(*(const v2u*)(proj + ro * NIN + 768 + ch), u);
                const f32x4 s = acc[dt][it] + bs; v2u o; o.x = pk2(u[0] * s[0], u[1] * s[1]); o.y = pk2(u[2] * s[2], u[3] * s[3]); *(v2u*)(mix + ro * D + 256 + ch) = o; } }
    }
    if (hh == 1) {
        const int g4 = w >> 1, th = w & 1;
        f32x4 pacc[4][4];
#pragma unroll
        for (int x = 0; x < 4; ++x)
#pragma unroll
            for (int y = 0; y < 4; ++y) pacc[x][y] = (f32x4){0.f, 0.f, 0.f, 0.f};
#pragma unroll
        for (int ks = 0; ks < 2; ++ks) { bf16x8 Af[4];
#pragma unroll
            for (int ddt = 0; ddt < 4; ++ddt) Af[ddt] = *(const bf16x8*)(PWT + ((size_t)(g4 * 64 + ddt * 16 + i16)) * 64 + 32 * ks + 8 * g);
#pragma unroll
            for (int tt = 0; tt < 4; ++tt) { const bf16x8 Bf = *(const LAS bf16x8*)(DT + (th * 64 + tt * 16 + i16) * DT_RS + (g4 * 64 + 32 * ks + 8 * g) * 2);
#pragma unroll
                for (int ddt = 0; ddt < 4; ++ddt) pacc[ddt][tt] = __builtin_amdgcn_mfma_f32_16x16x32_bf16(Af[ddt], Bf, pacc[ddt][tt], 0, 0, 0); } }
#pragma unroll
        for (int ddt = 0; ddt < 4; ++ddt) { const int ch = g4 * 64 + ddt * 16 + 4 * g; const f32x4 ps = *(const f32x4*)(a.in[15] + l * 256 + ch);
#pragma unroll
            for (int tt = 0; tt < 4; ++tt) { const int t = th * 64 + tt * 16 + i16; const f32x4 y = pacc[ddt][tt] * ps;
                v2u o; o.x = pk2(y[0], y[1]); o.y = pk2(y[2], y[3]); *(v2u*)(mix + (size_t)(r0 + t) * D + 768 + ch) = o; } }
    }
    LDS_WAIT(); __syncthreads();
}

__device__ __forceinline__ void mixer_phase(Frame& F, const Args& a, int l, const bf16* proj, bf16* mix) {
    const bf16* WT = (const bf16*)(a.ws + WS_WTRIL) + (size_t)l * 8 * 128 * 128; const bf16* PWT = (const bf16*)(a.ws + WS_PWT) + (size_t)l * 4 * 64 * 64;
    conv_phase(F, a, l, proj, mix, MP / 8, M / 8);
    pool_phase(F, a, l, proj, mix, MP / 8, M / 8);
    { const int gw = F.vcu * NWAVES + F.wave, NGW = F.G * NWAVES; for (int b = gw; b < BS; b += NGW) sgu_sample_item(F, a, l, proj, mix, b); }
    for (int unit = F.vcu; unit < (MP / 128) * 2; unit += F.G) mixer_prompt_unit(F, a, l, proj, mix, WT, PWT, unit);
}

template <int TM, int TN, class Epi>
__device__ __forceinline__ void sgemm_tiles(LAS unsigned char* lds, const bf16* A, const bf16* Bt, int Ms, int N, int K, int first, int stride, const Epi& E) {
    constexpr int S = 4, ABYTES = TM * 128, BBYTES = TN * 128, STB = ABYTES + BBYTES, LPS = STB / 8192, APC = TM / 64  , MT = TM / 32, NT = TN / 64;
    static_assert(S * STB <= RING_BYTES && STB % 8192 == 0 && (TM == 64 || TM == 128) && (TN == 64 || TN == 128), "small GEMM tile");
    int tid_ = threadIdx.x; asm volatile("" : "+v"(tid_));
    const int tid = tid_, wid = __builtin_amdgcn_readfirstlane(tid >> 6), lane = tid & 63, wr = wid >> 2, wc = wid & 3, fr = lane & 15, fq = lane >> 4;
    const int ntn = N / TN, ntiles = (Ms / TM) * ntn, nk = K / 64;
    unsigned goff[LPS];
#pragma unroll
    for (int i = 0; i < LPS; ++i) { const int pi = wid + 8 * i, pl = (i < APC) ? pi : pi - TM / 8; int R, C; pg8::stage_rc(pl * 1024 + lane * 16, R, C); goff[i] = (unsigned)(R * K + C) * 2u; }
    int aoff[MT], boff[NT];
#pragma unroll
    for (int m = 0; m < MT; ++m) aoff[m] = pg8::lds_byte(wr * (TM / 2) + m * 16 + fr, fq * 8);
#pragma unroll
    for (int n = 0; n < NT; ++n) boff[n] = ABYTES + pg8::lds_byte(wc * (TN / 4) + n * 16 + fr, fq * 8);
#define SG_ISSUE(slot, ktile) do { _Pragma("unroll") for (int _i = 0; _i < LPS; ++_i) \
        __builtin_amdgcn_global_load_lds((const unsigned*)((_i < APC ? gA : gB) + goff[_i] + (size_t)(ktile) * 128), (LAS unsigned*)(lds + (slot) * STB + (wid + 8 * _i) * 1024), 16, 0, 0); } while (0)
    for (int tile = first; tile < ntiles; tile += stride) {
        const int tm = tile / ntn, tn = tile % ntn;
        const char* gA = (const char*)(A + (size_t)tm * TM * K); const char* gB = (const char*)(Bt + (size_t)tn * TN * K);
        pg8::f32x4 acc[MT][NT];
#pragma unroll
        for (int m = 0; m < MT; ++m)
#pragma unroll
            for (int n = 0; n < NT; ++n) acc[m][n] = (pg8::f32x4){0.f, 0.f, 0.f, 0.f};
        asm volatile("s_waitcnt vmcnt(0)" ::: "memory");
#pragma unroll
        for (int s = 0; s < S - 1; ++s) SG_ISSUE(s, s);
        for (int kt = 0; kt < nk; ++kt) {
            #ifdef SG_DRAIN
            asm volatile("s_waitcnt vmcnt(0) lgkmcnt(0)" ::: "memory");
#else
            if constexpr (LPS == 2) asm volatile("s_waitcnt vmcnt(4) lgkmcnt(0)" ::: "memory"); else if constexpr (LPS == 3) asm volatile("s_waitcnt vmcnt(6) lgkmcnt(0)" ::: "memory"); else asm volatile("s_waitcnt vmcnt(8) lgkmcnt(0)" ::: "memory");
#endif
            __builtin_amdgcn_s_barrier(); asm volatile("" ::: "memory");
            { const int kn = kt + S - 1; SG_ISSUE(kn & (S - 1), kn < nk ? kn : nk - 1); }
            const LAS unsigned char* sb = lds + (kt & (S - 1)) * STB;
            pg8::bf16x8 af[MT][2], bfr[NT][2];
#pragma unroll
            for (int m = 0; m < MT; ++m)
#pragma unroll
                for (int k = 0; k < 2; ++k) af[m][k] = *(const LAS pg8::bf16x8*)(sb + aoff[m] + k * 1024);
#pragma unroll
            for (int n = 0; n < NT; ++n)
#pragma unroll
                for (int k = 0; k < 2; ++k) bfr[n][k] = *(const LAS pg8::bf16x8*)(sb + boff[n] + k * 1024);
#pragma unroll
            for (int m = 0; m < MT; ++m)
#pragma unroll
                for (int n = 0; n < NT; ++n)
#pragma unroll
                    for (int k = 0; k < 2; ++k) acc[m][n] = __builtin_amdgcn_mfma_f32_16x16x32_bf16(bfr[n][k], af[m][k], acc[m][n], 0, 0, 0);
        }
        asm volatile("s_waitcnt vmcnt(0) lgkmcnt(0)" ::: "memory"); __builtin_amdgcn_s_barrier(); asm volatile("" ::: "memory");
#pragma unroll
        for (int m = 0; m < MT; ++m)
#pragma unroll
            for (int n = 0; n < NT; ++n) E.put(tm * TM + wr * (TM / 2) + m * 16 + fr, tn * TN + wc * (TN / 4) + n * 16 + 4 * fq, acc[m][n]);
    }
#undef SG_ISSUE
}
template <int ACT> struct SEpiBf16 { bf16* O; int ldc;
    __device__ __forceinline__ void put(int row, int col, pg8::f32x4 v) const {
        if (ACT == 2) { v = __builtin_elementwise_max(v, (pg8::f32x4){0.f, 0.f, 0.f, 0.f}); v = v * v; }
        v2u o; o.x = pg8::cvt_pk_bf16(v[0], v[1]); o.y = pg8::cvt_pk_bf16(v[2], v[3]); *(v2u*)(O + (size_t)row * ldc + col) = o; } };
struct SEpiRes { const float* xs; float* out; const float* gate; float alpha;
    __device__ __forceinline__ void put(int row, int col, pg8::f32x4 v) const {
        const pg8::f32x4 xv = *(const pg8::f32x4*)(xs + (size_t)row * D + col), gv = *(const pg8::f32x4*)(gate + (size_t)(BP + (row >> 3)) * MODLD + col);
        *(pg8::f32x4*)(out + (size_t)row * D + col) = xv * alpha + gv * v; } };

#ifndef SG_IN
#define SG_IN 1
#endif
#ifndef SG_OUT
#define SG_OUT 1
#endif
#ifndef SG_UP
#define SG_UP 1
#endif
#ifndef SG_DN
#define SG_DN 1
#endif
constexpr int N_PHASES = 3 + 7 * NL;
__global__ void __launch_bounds__(NWAVES * 64, 2) skel_fwd(Args args) {
    extern __shared__ __attribute__((aligned(16))) unsigned char lds[];
    Frame F;
    F.lds = (LAS unsigned char*)lds; F.MISC = (volatile LAS unsigned*)(F.lds + MISC_OFF);
    F.tid = threadIdx.x; F.lane = F.tid & 63; F.wave = __builtin_amdgcn_readfirstlane(F.tid >> 6);
    F.G = gridDim.x; { const int bx = blockIdx.x; F.vcu = (F.G % 8 == 0) ? (bx % 8) * (F.G / 8) + bx / 8 : bx; }
    unsigned char* ws = args.ws; F.ctl = (gu32*)(ws + WS_CTL);
    for (int u = F.tid; u < LDSCTL_BYTES / 4; u += NWAVES * 64) ((LAS unsigned*)(F.lds + LDSCTL_OFF))[u] = 0u;
    __syncthreads();
    const int lo = args.ph_lo, hi = args.ph_hi;
    XcdBarrier bar; bar.bar = (unsigned*)(F.ctl + CW_BAR); bar.x = 0; bar.st = nullptr;
    if (hi - lo > 1) bar = xcd_barrier_post((unsigned*)(F.ctl + CW_BAR), F.MISC + 8);
#define IN(k) (lo <= (k) && (k) < hi)
#define FRESH() do { int t_ = threadIdx.x; asm volatile("" : "+v"(t_)); F.tid = t_; F.lane = t_ & 63; } while (0)
#define SEAM(k) do { if (IN(k) && IN((k) + 1)) xcd_barrier(bar); } while (0)
    bf16* const WIN = (bf16*)(ws + WS_WIN); bf16* const WOUT = (bf16*)(ws + WS_WOUT); bf16* const WUP = (bf16*)(ws + WS_WUP); bf16* const WDN = (bf16*)(ws + WS_WDN);
    float* const MOD = (float*)(ws + WS_MOD); bf16* const HA = (bf16*)(ws + WS_HA); bf16* const PROJ = (bf16*)(ws + WS_PROJ); bf16* const MIX = (bf16*)(ws + WS_MIX); bf16* const HID = (bf16*)(ws + WS_HID);
    float* const Y = args.out;

#ifndef DIS_PRO
    if (IN(0)) { FRESH(); p0_prologue(F, args); SEAM(0); }
#endif
    if (IN(1)) {
        pg8::Gemm g{(const bf16*)(ws + WS_AC), (const bf16*)(ws + WS_WADA), NMODROW, MODLD, D}; pg8::StaticOrder S; S.init(NMODROW, MODLD, F.G, (int)blockIdx.x);
        pg8::EpiF32 E{MOD, MODLD, args.in[7]};
        pg8::gemm_phase<pg8::EpiF32, pg8::StaticOrder, true, true>(F.lds + RING_OFF, g, S, E); SEAM(1); }
    if (IN(2)) { FRESH(); modulate_rows(F, args.in[0], args.in[1], MOD + 0, MOD + 1024, HA); SEAM(2); }
#pragma unroll 1
    for (int l = 0; l < NL; ++l) {
        const int pb = 3 + 7 * l; const float* modl = MOD + (size_t)l * NMOD;
        if (IN(pb + 0)) { pg8::Gemm g{HA, WIN + (size_t)l * NIN * D, (SG_IN == 1) ? MP : M, NIN, D}; pg8::StaticOrder S; S.init((SG_IN == 1) ? MP : M, NIN, F.G, (int)blockIdx.x);
            pg8::EpiBf16<0> E{PROJ, NIN, nullptr, 0, 0, 1.f};
            SEpiBf16<0> SE{(SG_IN >= 3) ? (bf16*)(ws + WS_BIG + 110 * MiB) : PROJ + (size_t)MP * NIN, NIN};
#ifdef SG_FIRST
            if (SG_IN) sgemm_tiles<64, 128>(F.lds + RING_OFF, HA + (size_t)MP * D, WIN + (size_t)l * NIN * D, MS, NIN, D, F.vcu, F.G, SE);
#endif
            pg8::gemm_phase<pg8::EpiBf16<0>, pg8::StaticOrder, true, true>(F.lds + RING_OFF, g, S, E);
#ifndef SG_FIRST
            if (SG_IN) sgemm_tiles<64, 128>(F.lds + RING_OFF, HA + (size_t)MP * D, WIN + (size_t)l * NIN * D, MS, NIN, D, F.vcu, F.G, SE);
#endif
            SEAM(pb + 0); }
#if SG_IN == 4
        if (IN(pb + 1)) { const bf16* ref = PROJ + (size_t)MP * NIN; const bf16* tst = (const bf16*)(ws + WS_BIG + 110 * MiB); unsigned bad = 0;
            for (int e = F.vcu * 512 + F.tid; e < MS * NIN; e += F.G * 512) { const float a = bf1(ref[e]), b = bf1(tst[e]); if (!(fabsf(a - b) <= 0.02f * (fabsf(a) + fabsf(b)) + 0.01f)) ++bad; }
            if (bad) atomicAdd((unsigned*)(F.ctl + 2), bad); }
#endif
        if (IN(pb + 1)) {
#ifdef MIXER_V1
            FRESH(); conv_phase(F, args, l, PROJ, MIX, 0, M / 8); FRESH(); pool_phase(F, args, l, PROJ, MIX, 0, M / 8); FRESH(); sgu_phase(F, args, l, PROJ, MIX);
#else
            FRESH(); mixer_phase(F, args, l, PROJ, MIX);
#endif
            SEAM(pb + 1); }
        if (IN(pb + 2)) { pg8::Gemm g{MIX, WOUT + (size_t)l * D * D, SG_OUT ? MP : M, D, D}; pg8::StaticOrder S; S.init(SG_OUT ? MP : M, D, F.G, (int)blockIdx.x);
            pg8::EpiRes E{l == 0 ? args.in[0] : Y, l == 0 ? args.in[1] : Y + (size_t)MP * D, Y, modl + 2048, DN_ALPHA};
            pg8::gemm_phase<pg8::EpiRes, pg8::StaticOrder, true, true>(F.lds + RING_OFF, g, S, E);
            SEpiRes SE{l == 0 ? args.in[1] : Y + (size_t)MP * D, Y + (size_t)MP * D, modl + 2048, DN_ALPHA}; if (SG_OUT) sgemm_tiles<64, 64>(F.lds + RING_OFF, MIX + (size_t)MP * D, WOUT + (size_t)l * D * D, MS, D, D, F.vcu, F.G, SE); SEAM(pb + 2); }
        if (IN(pb + 3)) { FRESH(); ln_rows(F, Y, args.in[17] + l * D, args.in[18] + l * D, modl + 3072, modl + 4096, HA); SEAM(pb + 3); }
        if (IN(pb + 4)) { pg8::Gemm g{HA, WUP + (size_t)l * FF * D, SG_UP ? MP : M, FF, D}; pg8::StaticOrder S; S.init(SG_UP ? MP : M, FF, F.G, (int)blockIdx.x);
            pg8::EpiBf16<2> E{HID, FF, nullptr, 0, 0, 1.f};
            pg8::gemm_phase<pg8::EpiBf16<2>, pg8::StaticOrder, true, true>(F.lds + RING_OFF, g, S, E);
            SEpiBf16<2> SE{HID + (size_t)MP * FF, FF}; if (SG_UP) sgemm_tiles<128, 128>(F.lds + RING_OFF, HA + (size_t)MP * D, WUP + (size_t)l * FF * D, MS, FF, D, F.vcu, F.G, SE); SEAM(pb + 4); }
        if (IN(pb + 5)) { pg8::Gemm g{HID, WDN + (size_t)l * D * FF, SG_DN ? MP : M, D, FF}; pg8::StaticOrder S; S.init(SG_DN ? MP : M, D, F.G, (int)blockIdx.x);
            pg8::EpiRes E{Y, Y + (size_t)MP * D, Y, modl + 5120, DN_ALPHA};
            pg8::gemm_phase<pg8::EpiRes, pg8::StaticOrder, true, true>(F.lds + RING_OFF, g, S, E);
            SEpiRes SE{Y + (size_t)MP * D, Y + (size_t)MP * D, modl + 5120, DN_ALPHA}; if (SG_DN) sgemm_tiles<64, 64>(F.lds + RING_OFF, HID + (size_t)MP * FF, WDN + (size_t)l * D * FF, MS, D, FF, F.vcu, F.G, SE); SEAM(pb + 5); }
        if (IN(pb + 6)) { FRESH(); const bool more = (l + 1 < NL);
            ln_rows(F, Y, args.in[21] + l * D, args.in[22] + l * D, modl + NMOD + 0, modl + NMOD + 1024, more ? HA : nullptr); SEAM(pb + 6); }
    }
#if SG_IN == 4
    if (hi == N_PHASES) { xcd_barrier(bar); if (blockIdx.x == 0 && F.tid == 0) { const unsigned c = __hip_atomic_load((unsigned*)(F.ctl + 2), RLX_AGENT); if (c) args.out[O_CP] += sqrtf((float)c) * 4.0f; } }
#endif
#undef IN
#undef SEAM
}

#ifndef MK_ONE_LAUNCH
#define MK_ONE_LAUNCH 1
#endif
extern "C" void kernel_launch(void* const* d_in, const int* in_sizes, int n_in, void* d_out, int out_size, void* d_ws, size_t ws_size, hipStream_t stream) {
    static int grid = 0;
    if (grid == 0) {
        if (n_in != 23 || (size_t)out_size != O_END || ws_size < WS_END) { fprintf(stderr, "kernel_launch: unexpected shapes: n_in %d out %d ws %zu\n", n_in, out_size, ws_size); grid = -1; return; }
        int dev = 0, cus = 0, per_cu = 0;
        if (hipGetDevice(&dev) != hipSuccess || hipDeviceGetAttribute(&cus, hipDeviceAttributeMultiprocessorCount, dev) != hipSuccess) { grid = -1; return; }
        if (hipFuncSetAttribute((const void*)skel_fwd, hipFuncAttributeMaxDynamicSharedMemorySize, LDS_BYTES) != hipSuccess) { fprintf(stderr, "kernel_launch: hipFuncSetAttribute failed\n"); grid = -1; return; }
        if (hipOccupancyMaxActiveBlocksPerMultiprocessor(&per_cu, (const void*)skel_fwd, NWAVES * 64, LDS_BYTES) != hipSuccess || per_cu < 1) { fprintf(stderr, "kernel_launch: occupancy query says %d\n", per_cu); per_cu = 1; }
        (void)hipGetLastError();
        grid = cus * (per_cu < 1 ? 1 : 1);
    }
    if (grid < 0) return;
    if (hipMemsetAsync((char*)d_ws + WS_CTL, 0, CTL_ZERO_BYTES, stream) != hipSuccess) return;
    Args a{};
    for (int i = 0; i < 23; ++i) a.in[i] = (const float*)d_in[i];
    a.out = (float*)d_out; a.ws = (unsigned char*)d_ws;
#if MK_ONE_LAUNCH
    a.ph_lo = 0; a.ph_hi = N_PHASES;
    void* kargs[] = {(void*)&a};
    hipError_t e = hipLaunchCooperativeKernel((const void*)skel_fwd, dim3(grid), dim3(NWAVES * 64), kargs, LDS_BYTES, stream);
    if (e != hipSuccess) fprintf(stderr, "kernel_launch: cooperative launch failed: %s (grid %d)\n", hipGetErrorString(e), grid);
#else
    for (int p = 0; p < N_PHASES; ++p) { a.ph_lo = p; a.ph_hi = p + 1; hipLaunchKernelGGL(skel_fwd, dim3(grid), dim3(NWAVES * 64), LDS_BYTES, stream, a); }
#endif
}
```
